# Optimizing an MI355X kernel written in HIP

```python
import jax, jax.numpy as jnp
from jax import lax
import numpy as np

D_MODEL = 4096
BATCH = 4
SEQ = 4096
DEPTH = 1

D_MIX = D_MODEL
D_GMLP = D_MIX // 2
GMLP_CHUNK = 128
GMLP_GROUPS = 16
GMLP_GROUP_DIM = D_GMLP // GMLP_GROUPS
D_MLSTM = D_MIX - D_GMLP
MLSTM_HEADS = 4
MLSTM_DV = D_MLSTM // MLSTM_HEADS
MLSTM_DQK = MLSTM_DV // 2
MLSTM_CHUNK = 64
GATE_SOFTCAP = 15.0
N_GROUPS = 8
EXPERTS_PER_GROUP = 8
N_EXPERTS = N_GROUPS * EXPERTS_PER_GROUP
TOP_K = 2
D_EXPERT = D_MODEL // 8
EXPERT_BLOCK = 128
EPS = 1e-6

PROJ_SIZES = (D_GMLP, D_GMLP,
              MLSTM_HEADS * MLSTM_DQK, MLSTM_HEADS * MLSTM_DQK,
              D_MLSTM, D_MLSTM,
              MLSTM_HEADS, MLSTM_HEADS)
D_IN_PROJ = sum(PROJ_SIZES)
PROJ_SPLITS = tuple(int(s) for s in np.cumsum(PROJ_SIZES)[:-1])

kernel_name = "hybrid_gmlp_mlstm_hmoe_block"


def rmsnorm(x, g):
    xf = x.astype(jnp.float32)
    y = xf * lax.rsqrt(jnp.mean(xf * xf, axis=-1, keepdims=True) + EPS)
    return (y * g.astype(jnp.float32)).astype(x.dtype)


def softcap(z):
    return GATE_SOFTCAP * jnp.tanh(z / GATE_SOFTCAP)


def gmlp_mixer(u, v, g_v, w_s, b_s):
    B, S, _ = u.shape
    u = jax.nn.gelu(u)
    v = rmsnorm(jax.nn.gelu(v), g_v)
    v = v.reshape(B, S // GMLP_CHUNK, GMLP_CHUNK, GMLP_GROUPS, GMLP_GROUP_DIM)
    causal = jnp.tril(jnp.ones((GMLP_CHUNK, GMLP_CHUNK), dtype=bool))
    w = jnp.where(causal[None], w_s, 0)
    z = jnp.einsum('gts,bnsgd->bntgd', w, v) + b_s.T[None, None, :, :, None]
    return u * z.reshape(B, S, D_GMLP).astype(u.dtype)


def mlstm_mixer(q, k, v, o, ig_pre, fg_pre, ig_b, fg_b, out_g):
    B, S, _ = q.shape
    H, L = MLSTM_HEADS, MLSTM_CHUNK
    NC = S // L
    f32 = jnp.float32

    def heads(t, d):
        return t.astype(f32).reshape(B, NC, L, H, d).transpose(1, 0, 3, 2, 4)

    def gates(t):
        return t.reshape(B, NC, L, H).transpose(1, 0, 3, 2)

    qh = heads(q, MLSTM_DQK)
    kh = heads(k, MLSTM_DQK) * (MLSTM_DQK ** -0.5)
    vh = heads(v, MLSTM_DV)
    ig = gates(softcap(ig_pre.astype(f32) + ig_b.astype(f32)))
    logf = gates(jax.nn.log_sigmoid(softcap(fg_pre.astype(f32) + fg_b.astype(f32))))
    causal = jnp.tril(jnp.ones((L, L), dtype=bool))

    def step(carry, xs):
        C, n, m = carry
        qc, kc, vc, igc, lfc = xs
        b = jnp.cumsum(lfc, axis=-1)
        d_log = jnp.where(causal, b[..., :, None] - b[..., None, :] + igc[..., None, :], -jnp.inf)
        inter = b + m[..., None]
        m_row = jnp.maximum(inter, jnp.max(d_log, axis=-1))
        w_intra = jnp.exp(d_log - m_row[..., None])
        w_inter = jnp.exp(inter - m_row)
        s = jnp.einsum('bhid,bhjd->bhij', qc, kc) * w_intra
        num = (w_inter[..., None] * jnp.einsum('bhid,bhde->bhie', qc, C)
               + jnp.einsum('bhij,bhje->bhie', s, vc))
        den = w_inter * jnp.einsum('bhid,bhd->bhi', qc, n) + jnp.sum(s, axis=-1)
        h = num / jnp.maximum(jnp.abs(den), jnp.exp(-m_row))[..., None]
        b_last = b[..., -1]
        tail = b_last[..., None] - b + igc
        m_new = jnp.maximum(b_last + m, jnp.max(tail, axis=-1))
        w_tail = jnp.exp(tail - m_new[..., None])
        decay = jnp.exp(b_last + m - m_new)
        C_new = decay[..., None, None] * C + jnp.einsum('bhj,bhjd,bhje->bhde', w_tail, kc, vc)
        n_new = decay[..., None] * n + jnp.einsum('bhj,bhjd->bhd', w_tail, kc)
        return (C_new, n_new, m_new), h

    init = (jnp.zeros((B, H, MLSTM_DQK, MLSTM_DV), f32),
            jnp.zeros((B, H, MLSTM_DQK), f32),
            jnp.zeros((B, H), f32))
    _, h = lax.scan(step, init, (qh, kh, vh, ig, logf))
    h = h.transpose(1, 0, 3, 2, 4).reshape(B, S, H, MLSTM_DV)
    h = h * lax.rsqrt(jnp.mean(h * h, axis=-1, keepdims=True) + EPS)
    h = h * out_g.astype(f32).reshape(H, MLSTM_DV)
    h = h.reshape(B, S, D_MLSTM) * jax.nn.sigmoid(o.astype(f32))
    return h.astype(q.dtype)


def hierarchical_moe(xn, wr_g, br_g, wr_e, br_e, w_gate, w_up, w_down):
    B, S, D = xn.shape
    N = B * S
    A = N * TOP_K
    xt = xn.reshape(N, D)
    xf = xt.astype(jnp.float32)
    g_logits = xf @ wr_g.astype(jnp.float32) + br_g.astype(jnp.float32)
    g_prob = jax.nn.softmax(g_logits, axis=-1)
    g_sel = jnp.argmax(g_logits, axis=-1)
    e_logits = (xf @ wr_e.astype(jnp.float32) + br_e.astype(jnp.float32)).reshape(N, N_GROUPS, EXPERTS_PER_GROUP)
    e_sel_logits = jnp.take_along_axis(e_logits, g_sel[:, None, None], axis=1)[:, 0]
    top_v, top_i = lax.top_k(e_sel_logits, TOP_K)
    weights = jax.nn.softmax(top_v, axis=-1) * jnp.take_along_axis(g_prob, g_sel[:, None], axis=1)
    expert_id = (g_sel[:, None] * EXPERTS_PER_GROUP + top_i).reshape(A)
    token_id = jnp.repeat(jnp.arange(N, dtype=jnp.int32), TOP_K)
    wts = weights.reshape(A)

    order = jnp.argsort(expert_id)
    e_s, tok_s, w_s = expert_id[order], token_id[order], wts[order]
    counts = jnp.zeros((N_EXPERTS,), jnp.int32).at[expert_id].add(1)
    padded = ((counts + EXPERT_BLOCK - 1) // EXPERT_BLOCK) * EXPERT_BLOCK
    pad_end = jnp.cumsum(padded)
    pad_start = pad_end - padded
    cnt_start = jnp.cumsum(counts) - counts
    pos = pad_start[e_s] + jnp.arange(A, dtype=jnp.int32) - cnt_start[e_s]
    NB = -(-(A + N_EXPERTS * (EXPERT_BLOCK - 1)) // EXPERT_BLOCK)
    P = NB * EXPERT_BLOCK
    tok_buf = jnp.full((P,), N, jnp.int32).at[pos].set(tok_s)
    w_buf = jnp.zeros((P,), jnp.float32).at[pos].set(w_s)
    block_start = jnp.arange(NB, dtype=jnp.int32) * EXPERT_BLOCK
    block_e = jnp.minimum(jnp.sum(block_start[:, None] >= pad_end[None, :], axis=1), N_EXPERTS - 1)
    x_pad = jnp.concatenate([xt, jnp.zeros((1, D), xt.dtype)], axis=0)

    def run_block(args):
        idx, e, wb = args
        xb = x_pad[idx]
        hb = jax.nn.silu(xb @ w_gate[e]) * (xb @ w_up[e])
        return ((hb @ w_down[e]).astype(jnp.float32) * wb[:, None]).astype(xn.dtype)

    out = lax.map(run_block, (tok_buf.reshape(NB, EXPERT_BLOCK), block_e, w_buf.reshape(NB, EXPERT_BLOCK)))
    y = jax.ops.segment_sum(out.reshape(P, D), tok_buf, num_segments=N + 1)[:N]
    return y.reshape(B, S, D).astype(xn.dtype)


def setup_inputs(seed: int = 0) -> dict:
    key = jax.random.key(seed)
    ks = jax.random.split(key, 20)
    f32 = jnp.float32
    nrm = lambda k, shape, s: jax.random.normal(k, shape, f32) * s
    return {
        "x": nrm(ks[0], (BATCH, SEQ, D_MODEL), 1.0),
        "norm_mix_g": 1.0 + nrm(ks[1], (DEPTH, D_MODEL), 0.02),
        "w_in": nrm(ks[2], (DEPTH, D_MODEL, D_IN_PROJ), D_MODEL ** -0.5),
        "gmlp_v_norm_g": 1.0 + nrm(ks[3], (DEPTH, D_GMLP), 0.02),
        "gmlp_spatial_w": nrm(ks[4], (DEPTH, GMLP_GROUPS, GMLP_CHUNK, GMLP_CHUNK), GMLP_CHUNK ** -0.5),
        "gmlp_spatial_b": 1.0 + nrm(ks[5], (DEPTH, GMLP_GROUPS, GMLP_CHUNK), 0.02),
        "mlstm_igate_b": nrm(ks[6], (DEPTH, MLSTM_HEADS), 0.1),
        "mlstm_fgate_b": 3.0 + nrm(ks[7], (DEPTH, MLSTM_HEADS), 0.5),
        "mlstm_out_norm_g": 1.0 + nrm(ks[8], (DEPTH, D_MLSTM), 0.02),
        "w_out": nrm(ks[9], (DEPTH, D_MIX, D_MODEL), D_MIX ** -0.5),
        "norm_ffn_g": 1.0 + nrm(ks[10], (DEPTH, D_MODEL), 0.02),
        "router_group_w": nrm(ks[11], (DEPTH, D_MODEL, N_GROUPS), D_MODEL ** -0.5),
        "router_group_b": nrm(ks[12], (DEPTH, N_GROUPS), 0.01),
        "router_expert_w": nrm(ks[13], (DEPTH, D_MODEL, N_EXPERTS), D_MODEL ** -0.5),
        "router_expert_b": nrm(ks[14], (DEPTH, N_EXPERTS), 0.01),
        "expert_w_gate": nrm(ks[15], (DEPTH, N_EXPERTS, D_MODEL, D_EXPERT), D_MODEL ** -0.5),
        "expert_w_up": nrm(ks[16], (DEPTH, N_EXPERTS, D_MODEL, D_EXPERT), D_MODEL ** -0.5),
        "expert_w_down": nrm(ks[17], (DEPTH, N_EXPERTS, D_EXPERT, D_MODEL), D_EXPERT ** -0.5),
        "final_norm_g": 1.0 + nrm(ks[18], (D_MODEL,), 0.02),
    }


def reference(x, norm_mix_g, w_in, gmlp_v_norm_g, gmlp_spatial_w, gmlp_spatial_b,
              mlstm_igate_b, mlstm_fgate_b, mlstm_out_norm_g, w_out, norm_ffn_g,
              router_group_w, router_group_b, router_expert_w, router_expert_b,
              expert_w_gate, expert_w_up, expert_w_down, final_norm_g):
    for l in range(DEPTH):
        xn = rmsnorm(x, norm_mix_g[l])
        proj = xn @ w_in[l]
        u_a, v_a, q_b, k_b, v_b, o_b, i_b, f_b = jnp.split(proj, PROJ_SPLITS, axis=-1)
        y_a = gmlp_mixer(u_a, v_a, gmlp_v_norm_g[l], gmlp_spatial_w[l], gmlp_spatial_b[l])
        y_b = mlstm_mixer(q_b, k_b, v_b, o_b, i_b, f_b, mlstm_igate_b[l], mlstm_fgate_b[l],
                          mlstm_out_norm_g[l])
        x = x + jnp.concatenate([y_a, y_b], axis=-1) @ w_out[l]
        x = x + hierarchical_moe(rmsnorm(x, norm_ffn_g[l]), router_group_w[l], router_group_b[l],
                                 router_expert_w[l], router_expert_b[l], expert_w_gate[l],
                                 expert_w_up[l], expert_w_down[l])
    return rmsnorm(x, final_norm_g)
```

```cpp
#include <hip/hip_runtime.h>
#include <cstdio>
#include <cstdint>

#ifndef MK_N_LAUNCHES
#define MK_N_LAUNCHES 1
#endif

#define LAS __attribute__((address_space(3)))
#define GAS __attribute__((address_space(1)))
typedef unsigned short bf16_t;
typedef short bf16x8 __attribute__((ext_vector_type(8)));
typedef float f32x4 __attribute__((ext_vector_type(4)));
typedef float f32x2 __attribute__((ext_vector_type(2)));
typedef unsigned u32x4 __attribute__((ext_vector_type(4)));
typedef unsigned u32x2 __attribute__((ext_vector_type(2)));

constexpr int DM = 4096, NTOK = 16384, SEQL = 4096;
constexpr int NPROJ = 10240, LDW_IN = 10248;
constexpr int C_U = 0, C_V = 2048, C_Q = 4096, C_K = 5120, C_VB = 6144, C_O = 8192;
constexpr int NEXP = 64, DEXP = 512, LISTCAP = 16384;
constexpr float EPS = 1e-6f;

constexpr size_t MiB = 1u << 20;
constexpr size_t WS_CTL = 0, CTL_ZERO_BYTES = 1 * MiB;
constexpr size_t WS_GATES = 1 * MiB;
constexpr size_t WS_RSTD2 = 1 * MiB + 512 * 1024;
constexpr size_t WS_AW = WS_RSTD2 + 64 * 1024;
constexpr size_t WS_APOS = WS_AW + 128 * 1024;
constexpr size_t WS_WRT = 2 * MiB;
constexpr size_t WS_LIST = 3 * MiB;
constexpr size_t WS_GS = 7 * MiB;
constexpr size_t WS_WIN = 8 * MiB;
constexpr size_t WS_WOUT = 88 * MiB;
constexpr size_t WS_WGU = 120 * MiB;
constexpr size_t WS_WD = 632 * MiB;
constexpr size_t WS_ACT = 888 * MiB;
constexpr size_t WS_PROJ = 1016 * MiB;
constexpr size_t WS_YT = WS_PROJ;
constexpr size_t WS_HM = 1464 * MiB;
constexpr size_t WS_PM = WS_HM;
constexpr size_t WS_KP = WS_HM + 16 * MiB;
constexpr size_t WS_HB = 1336 * MiB;
constexpr size_t WS_QH = 1512 * MiB;
constexpr size_t WS_KH = 1544 * MiB;
constexpr size_t WS_VH = 1576 * MiB;
constexpr size_t WS_X1 = 1640 * MiB;
constexpr size_t WS_VSSP = 1768 * MiB;
constexpr size_t WS_END = 1770 * MiB;
constexpr int CW_BAR = 4096;
constexpr int CW_CNT = 16384;
constexpr int CW_QA = 26624, CW_QB = 26688;
constexpr int CW_Q1 = 24576;

constexpr int LDS_BYTES = 147456;
constexpr int TAB_OFF = 131072;
constexpr int MISC_OFF = LDS_BYTES - 512;
constexpr int PTAB_OFF = MISC_OFF + 256;

__device__ __forceinline__ unsigned f2bf(float f) { unsigned u = __builtin_bit_cast(unsigned, f); return (u + 0x7fffu + ((u >> 16) & 1u)) >> 16; }
__device__ __forceinline__ float bf2f(unsigned b) { return __builtin_bit_cast(float, b << 16); }
__device__ __forceinline__ unsigned pk2(float lo, float hi) { return f2bf(lo) | (f2bf(hi) << 16); }
__device__ __forceinline__ float bf_lo(unsigned w) { return __builtin_bit_cast(float, w << 16); }
__device__ __forceinline__ float bf_hi(unsigned w) { return __builtin_bit_cast(float, w & 0xffff0000u); }
__device__ __forceinline__ float wave_sum(float v) {
#pragma unroll
    for (int o = 1; o < 64; o <<= 1) v += __shfl_xor(v, o);
    return v;
}
__device__ __forceinline__ float fast_exp(float x) { return __builtin_amdgcn_exp2f(x * 1.4426950408889634f); }
__device__ __forceinline__ float gelu_tanh(float x) {
    const float t = x * (1.0f + 0.044715f * x * x) * 1.5957691216057308f;
    return x * __builtin_amdgcn_rcpf(1.0f + fast_exp(-t));
}
__device__ __forceinline__ float sigmoid_f(float x) { return __builtin_amdgcn_rcpf(1.0f + fast_exp(-x)); }
__device__ __forceinline__ unsigned cvtpk(float lo, float hi) { unsigned r; asm volatile("v_cvt_pk_bf16_f32 %0, %1, %2" : "=v"(r) : "v"(lo), "v"(hi)); return r; }
#define LDS_WAIT() asm volatile("s_waitcnt lgkmcnt(0)" ::: "memory")
#define VM_WAIT() asm volatile("s_waitcnt vmcnt(0)" ::: "memory")
#define LDS_BARRIER() do { asm volatile("s_waitcnt lgkmcnt(0)" ::: "memory"); __builtin_amdgcn_s_barrier(); asm volatile("" ::: "memory"); } while (0)
__device__ __forceinline__ f32x4 mfma16(bf16x8 a, bf16x8 b, f32x4 c) { return __builtin_amdgcn_mfma_f32_16x16x32_bf16(a, b, c, 0, 0, 0); }

namespace pg8 {
constexpr int BM = 256, BK = 64, HALF = 128, HTB = HALF * BK * 2, STAGE_BYTES = 8 * HTB, NXCD = 8, WGM = 8;
__host__ __device__ __forceinline__ int lds_byte(int r, int c) { const int st = (r >> 4) * 2 + (c >> 5), rr = r & 15, cc = c & 31, ob = rr * 64 + cc * 2; return st * 1024 + (ob ^ (((ob >> 9) & 1) << 5)); }
__host__ __device__ __forceinline__ void stage_rc(int b, int& R, int& C) { const int st = b / 1024, sb = b % 1024, swz = sb ^ (((sb >> 9) & 1) << 5); R = (st >> 1) * 16 + swz / 64; C = (st & 1) * 32 + (swz % 64) / 2; }
__host__ __device__ __forceinline__ int perm32(int rho) { const int n = rho >> 4, i = rho & 15; return 8 * (i >> 2) + 4 * n + (i & 3); }

struct Unit { int pm, pn, e, nvalid, rowbase; };

template <int K> struct DenseSched {
    int nM, nN, nwg, G, c; const char* A; const char* Bt;
    __device__ void init(int M, int N, int G_, int c_, const void* A_, const void* Bt_) { nM = M / BM; nN = N / BM; nwg = nM * nN; G = G_; c = c_; A = (const char*)A_; Bt = (const char*)Bt_; }
    __device__ __forceinline__ bool next(int i, Unit& u) const {
        const long L = (long)i * G + c; if (L >= nwg) return false;
        int wgid = (int)L; { const int q = nwg / NXCD, r = nwg % NXCD, xcd = wgid % NXCD, off = wgid / NXCD; wgid = (xcd < r ? xcd * (q + 1) : r * (q + 1) + (xcd - r) * q) + off; }
        const int nig = WGM * nN, gid = wgid / nig, fm = gid * WGM, gsz = (nM - fm) < WGM ? (nM - fm) : WGM;
        u.pm = fm + ((wgid % nig) % gsz); u.pn = (wgid % nig) / gsz; u.e = 0; u.nvalid = 256; u.rowbase = u.pm * 256; return true;
    }
    __device__ __forceinline__ const char* a_base() const { return A; }
    __device__ __forceinline__ unsigned a_off(const Unit& u, int row) const { return (unsigned)(u.pm * 256 + row) * (unsigned)(K * 2); }
    __device__ __forceinline__ const char* b_ptr(const Unit& u) const { return Bt + (size_t)u.pn * 256 * K * 2; }
};
template <int K> struct DynSched {
    int nM, nN, nwg, xcc; const char* A; const char* Bt; unsigned* ctr; volatile LAS int* slot; bool t0;
    __device__ void init(int M, int N, const void* A_, const void* Bt_, unsigned* ctr_, volatile LAS int* slot_, int xcc_) { nM = M / BM; nN = N / BM; nwg = nM * nN; A = (const char*)A_; Bt = (const char*)Bt_; ctr = ctr_; slot = slot_; xcc = xcc_ & 7; }
    __device__ __forceinline__ int draw() const {
        const int per = nwg / NXCD;
        for (int a = 0; a < NXCD; ++a) { const int x = (xcc + a) & 7; const int n = (int)__hip_atomic_fetch_add(ctr + 64 * x, 1u, __ATOMIC_RELAXED, __HIP_MEMORY_SCOPE_AGENT); if (n < per) return NXCD * n + x; }
        return nwg;
    }
    __device__ __forceinline__ void prime() const {
        if (t0) { slot[0] = draw(); slot[1] = draw(); }
        __syncthreads();
    }
    __device__ __forceinline__ bool next(int i, Unit& u) const {
        const int L = __builtin_amdgcn_readfirstlane(slot[i & 3]);
        if (i >= 1 && t0) slot[(i + 1) & 3] = (L < nwg) ? draw() : nwg;
        if (L >= nwg) return false;
        int wgid = L; { const int q = nwg / NXCD, r = nwg % NXCD, xcd = wgid % NXCD, off = wgid / NXCD; wgid = (xcd < r ? xcd * (q + 1) : r * (q + 1) + (xcd - r) * q) + off; }
        const int nig = WGM * nN, gid = wgid / nig, fm = gid * WGM, gsz = (nM - fm) < WGM ? (nM - fm) : WGM;
        u.pm = fm + ((wgid % nig) % gsz); u.pn = (wgid % nig) / gsz; u.e = 0; u.nvalid = 256; u.rowbase = u.pm * 256; return true;
    }
    __device__ __forceinline__ const char* a_base() const { return A; }
    __device__ __forceinline__ unsigned a_off(const Unit& u, int row) const { return (unsigned)(u.pm * 256 + row) * (unsigned)(K * 2); }
    __device__ __forceinline__ const char* b_ptr(const Unit& u) const { return Bt + (size_t)u.pn * 256 * K * 2; }
};
template <int K, int NPN_SHIFT, bool GATHER, bool DYN = false> struct MoeSched {
    const LAS int* cnts; const LAS int* tstart; const LAS int* tl; int u_lo, u_hi, G, c; const int* list; const char* A; const char* Bt; size_t bexp;
    unsigned* ctr; volatile LAS int* slot; bool t0;
    __device__ __forceinline__ int draw() const { return (int)__hip_atomic_fetch_add(ctr, 1u, __ATOMIC_RELAXED, __HIP_MEMORY_SCOPE_AGENT); }
    __device__ __forceinline__ void prime() const { if (t0) { slot[0] = draw(); slot[1] = draw(); } __syncthreads(); }
    __device__ __forceinline__ bool next(int i, Unit& u) const {
        int L;
        if (DYN) { const int n = __builtin_amdgcn_readfirstlane(slot[i & 3]); const int cntu = u_hi - u_lo;
            if (i >= 1 && t0) slot[(i + 1) & 3] = (n < cntu) ? draw() : cntu;
            if (n >= cntu) return false; L = u_lo + n; }
        else { L = u_lo + i * G + c; if (L >= u_hi) return false; }
        const int pk = __builtin_amdgcn_readfirstlane(tl[L >> NPN_SHIFT]); const int e = pk >> 8;
        u.pn = L & ((1 << NPN_SHIFT) - 1); u.e = e; u.pm = pk & 255;
        int nv = cnts[e] - u.pm * 256; nv = nv > 256 ? 256 : nv; u.nvalid = __builtin_amdgcn_readfirstlane(nv); u.rowbase = __builtin_amdgcn_readfirstlane((tstart[e] + u.pm) * 256); return true;
    }
    __device__ __forceinline__ const char* a_base() const { return A; }
    __device__ __forceinline__ unsigned a_off(const Unit& u, int row) const {
        if (GATHER) { int tok = 0; if (row < u.nvalid) tok = list[u.e * LISTCAP + u.pm * 256 + row] >> 1; return (unsigned)tok * (unsigned)(K * 2); }
        else return (unsigned)(u.rowbase + row) * (unsigned)(K * 2);
    }
    __device__ __forceinline__ const char* b_ptr(const Unit& u) const { return Bt + (size_t)u.e * bexp + (size_t)u.pn * 256 * K * 2; }
};

__device__ __forceinline__ unsigned cvt_pk_bf16(float lo, float hi) { unsigned r; asm volatile("v_cvt_pk_bf16_f32 %0, %1, %2" : "=v"(r) : "v"(lo), "v"(hi)); return r; }

template <class Epi, class Sched, int K, bool SKIP = false>
__device__ __forceinline__ void gemm_phase(LAS unsigned char* lds, const Sched& S, const Epi& E, const int wid, const int lane) {
    const int tid = wid * 64 + lane, wr = wid >> 2, wc = wid & 3, fr = lane & 15, fq = lane >> 4;
    constexpr int nt = K / BK;
    unsigned voffB[2]; int RA[2]; unsigned CA2[2];
#pragma unroll
    for (int i = 0; i < 2; ++i) { int R, C; stage_rc(tid * 16 + i * 8192, R, C); const int Rb = Epi::PERM ? ((R & ~31) + perm32(R & 31)) : R;
        RA[i] = R; CA2[i] = (unsigned)C * 2u; voffB[i] = (unsigned)(Rb * K + C) * 2u; }
    constexpr size_t kstep = (size_t)(BK * 2);
    constexpr size_t hstep = (size_t)HALF * K * 2;
    const unsigned ldsw = (unsigned)wid * 1024u;
    const int aoffl = lds_byte(wr * 64 + fr, fq * 8), boffl = lds_byte(wc * 32 + fr, fq * 8);
#define PG8_SA(b, h) (((b) * 2 + (h)) * HTB)
#define PG8_SB(b, h) ((4 + (b) * 2 + (h)) * HTB)
#define PG8_STAGE(bufoff, gbase, voff) do { _Pragma("unroll") for (int _i = 0; _i < 2; ++_i) \
        __builtin_amdgcn_global_load_lds((const unsigned*)((const char*)(gbase) + (voff)[_i]), (LAS unsigned*)(lds + (bufoff) + ldsw + _i * 8192), 16, 0, 0); } while (0)
#define PG8_LDA(dst, b, h) do { _Pragma("unroll") for (int m = 0; m < 4; ++m) _Pragma("unroll") for (int k = 0; k < 2; ++k) dst[m][k] = *(const LAS bf16x8*)(lds + PG8_SA(b, h) + aoffl + m * 2048 + k * 1024); } while (0)
#define PG8_LDB(dst, b, h) do { _Pragma("unroll") for (int n = 0; n < 2; ++n) _Pragma("unroll") for (int k = 0; k < 2; ++k) dst[n][k] = *(const LAS bf16x8*)(lds + PG8_SB(b, h) + boffl + n * 2048 + k * 1024); } while (0)
#define PG8_MMA(ai, bj, At, Bt) do { if (SKIP && !((ai) ? doA1 : doA0)) break; __builtin_amdgcn_s_setprio(1); _Pragma("unroll") for (int m = 0; m < 4; ++m) _Pragma("unroll") for (int n = 0; n < 2; ++n) _Pragma("unroll") for (int k = 0; k < 2; ++k) \
        acc[ai][bj][m][n] = __builtin_amdgcn_mfma_f32_16x16x32_bf16(Bt[n][k], At[m][k], acc[ai][bj][m][n], 0, 0, 0); __builtin_amdgcn_s_setprio(0); } while (0)
#define PG8_WAIT_V(n) asm volatile("s_waitcnt vmcnt(" #n ")" ::: "memory")
#define PG8_WAIT_L(n) asm volatile("s_waitcnt lgkmcnt(" #n ")" ::: "memory")
#define PG8_BAR __builtin_amdgcn_s_barrier()
#define PG8_SCHED __builtin_amdgcn_sched_barrier(0)
#define PG8_LOAD_AOFF(u) do { _Pragma("unroll") for (int _h = 0; _h < 2; ++_h) _Pragma("unroll") for (int _i = 0; _i < 2; ++_i) aoff[_h][_i] = S.a_off(u, _h * HALF + RA[_i]) + CA2[_i]; } while (0)
    Unit cur, nxt; int ui = 0;
    if (!S.next(0, cur)) return;
    f32x4 acc[2][2][4][2];
#pragma unroll
    for (int a = 0; a < 2; ++a)
#pragma unroll
        for (int b = 0; b < 2; ++b)
#pragma unroll
            for (int m = 0; m < 4; ++m)
#pragma unroll
                for (int n = 0; n < 2; ++n) acc[a][b][m][n] = (f32x4){0.f, 0.f, 0.f, 0.f};
    bf16x8 At[4][2], B0[2][2], B1[2][2];
    unsigned aoff[2][2];
    const char* const Ab = S.a_base();
    const char* cB = S.b_ptr(cur);
    PG8_LOAD_AOFF(cur);
    PG8_STAGE(PG8_SB(0, 0), cB, voffB); PG8_STAGE(PG8_SB(0, 1), cB + hstep, voffB); PG8_STAGE(PG8_SA(0, 0), Ab, aoff[0]); PG8_STAGE(PG8_SA(0, 1), Ab, aoff[1]);
    if (wr == 1) PG8_BAR;
    PG8_WAIT_V(2); PG8_BAR;
    PG8_STAGE(PG8_SB(1, 0), cB + kstep, voffB); PG8_STAGE(PG8_SA(1, 0), Ab + kstep, aoff[0]); PG8_STAGE(PG8_SB(1, 1), cB + hstep + kstep, voffB);
    PG8_WAIT_V(6); PG8_BAR;
    for (;;) {
        const bool has_next = S.next(ui + 1, nxt);
        const bool doA1 = cur.nvalid > 128, doA0 = (wr == 0) || (cur.nvalid > 64);
        const char* nB = has_next ? S.b_ptr(nxt) : cB;
        const char* pA = Ab;
        for (int t = 0; t < nt; t += 2) {
            const bool last = (t == nt - 2);
            const char* b2 = last ? nB : cB + (size_t)(t + 2) * kstep;
            const char* b3 = b2 + kstep;
            PG8_LDB(B0, 0, 0); PG8_LDB(B1, 0, 1); PG8_SCHED; if (!SKIP || doA0) PG8_LDA(At, 0, 0); PG8_STAGE(PG8_SA(1, 1), pA + (size_t)(t + 1) * kstep, aoff[1]);
            if (last) {
                if (has_next) { PG8_LOAD_AOFF(nxt); }
                pA = Ab - (size_t)(t + 2) * kstep;
            }
            PG8_WAIT_V(8); PG8_WAIT_L(0); PG8_BAR; PG8_MMA(0, 0, At, B0); PG8_MMA(0, 1, At, B1); PG8_BAR; PG8_SCHED;
            if (!SKIP || doA1) PG8_LDA(At, 0, 1); PG8_STAGE(PG8_SB(0, 0), b2, voffB); PG8_STAGE(PG8_SB(0, 1), b2 + hstep, voffB); PG8_STAGE(PG8_SA(0, 0), pA + (size_t)(t + 2) * kstep, aoff[0]);
            PG8_WAIT_V(8); PG8_WAIT_L(0); PG8_BAR; PG8_MMA(1, 0, At, B0); PG8_MMA(1, 1, At, B1); PG8_BAR; PG8_SCHED;
            PG8_LDB(B0, 1, 0); PG8_LDB(B1, 1, 1); PG8_SCHED; if (!SKIP || doA0) PG8_LDA(At, 1, 0); PG8_STAGE(PG8_SA(0, 1), pA + (size_t)(t + 2) * kstep, aoff[1]);
            PG8_WAIT_V(8); PG8_WAIT_L(0); PG8_BAR; PG8_MMA(0, 0, At, B0); PG8_MMA(0, 1, At, B1); PG8_BAR; PG8_SCHED;
            if (!SKIP || doA1) PG8_LDA(At, 1, 1); PG8_STAGE(PG8_SB(1, 0), b3, voffB); PG8_STAGE(PG8_SB(1, 1), b3 + hstep, voffB); PG8_STAGE(PG8_SA(1, 0), pA + (size_t)(t + 3) * kstep, aoff[0]);
            PG8_WAIT_V(8); PG8_WAIT_L(0); PG8_BAR; PG8_MMA(1, 0, At, B0); PG8_MMA(1, 1, At, B1); PG8_BAR; PG8_SCHED;
        }
        if (wr == 0) PG8_BAR;
        E(acc, cur, wr, wc, fr, fq);
        if (!has_next) break;
#pragma unroll
        for (int a = 0; a < 2; ++a)
#pragma unroll
            for (int b = 0; b < 2; ++b)
#pragma unroll
                for (int m = 0; m < 4; ++m)
#pragma unroll
                    for (int n = 0; n < 2; ++n) acc[a][b][m][n] = (f32x4){0.f, 0.f, 0.f, 0.f};
        cur = nxt; cB = nB; ++ui;
        if (wr == 1) PG8_BAR;
    }
    PG8_WAIT_V(0);
    PG8_BAR;
#undef PG8_SA
#undef PG8_SB
#undef PG8_STAGE
#undef PG8_LDA
#undef PG8_LDB
#undef PG8_MMA
#undef PG8_WAIT_V
#undef PG8_WAIT_L
#undef PG8_BAR
#undef PG8_SCHED
#undef PG8_LOAD_AOFF
}

struct EpiProj {
    static constexpr bool PERM = true;
    bf16_t* O; bf16_t* QH; bf16_t* KH; bf16_t* VH; float* VSSP;
    __device__ __forceinline__ void operator()(const f32x4 (&acc)[2][2][4][2], const Unit& u, int wr, int wc, int fr, int fq) const {
        const int act = (u.pn < 16) ? 1 : ((u.pn >= 32) ? 2 : 0);
        const float sc = (u.pn >= 20 && u.pn < 24) ? 0.0625f : 1.0f;
        const int row0 = u.pm * BM + wr * 64 + fr;
        bf16_t* base = O + (size_t)u.pn * BM; size_t pitch = NPROJ; size_t hoff = 0;
        if (u.pn >= 16 && u.pn < 24) { const int hh = (u.pn - 16) & 3; base = (u.pn < 20) ? QH : KH; pitch = 256; hoff = (size_t)hh * SEQL * 256; }
        else if (u.pn >= 24 && u.pn < 32) { const int hh = (u.pn - 24) >> 1; base = VH + ((u.pn - 24) & 1) * 256; pitch = 512; hoff = (size_t)hh * SEQL * 512; }
        const int col0 = wc * 32 + 8 * fq; const bool headmajor = (u.pn >= 16 && u.pn < 32);
#pragma unroll
        for (int ai = 0; ai < 2; ++ai)
#pragma unroll
            for (int m = 0; m < 4; ++m) { const int row = row0 + ai * HALF + m * 16;
                bf16_t* rowp = headmajor ? base + (size_t)(row >> 12) * 4 * SEQL * pitch + hoff + (size_t)(row & (SEQL - 1)) * pitch + col0 : base + (size_t)row * pitch + col0;
                float vss = 0.f;
#pragma unroll
                for (int bj = 0; bj < 2; ++bj) { f32x4 v0 = acc[ai][bj][m][0], v1 = acc[ai][bj][m][1];
                    if (act == 1) {
#pragma unroll
                        for (int j = 0; j < 4; ++j) { v0[j] = gelu_tanh(v0[j]); v1[j] = gelu_tanh(v1[j]); vss += v0[j] * v0[j] + v1[j] * v1[j]; } }
                    else if (act == 2) {
#pragma unroll
                        for (int j = 0; j < 4; ++j) { v0[j] = sigmoid_f(v0[j]); v1[j] = sigmoid_f(v1[j]); } }
                    else { v0 = v0 * sc; v1 = v1 * sc; }
                    u32x4 w; w.x = cvt_pk_bf16(v0[0], v0[1]); w.y = cvt_pk_bf16(v0[2], v0[3]); w.z = cvt_pk_bf16(v1[0], v1[1]); w.w = cvt_pk_bf16(v1[2], v1[3]);
                    *(u32x4*)(rowp + bj * HALF) = w; }
                if (u.pn >= 8 && u.pn < 16) { vss += __shfl_xor(vss, 16); vss += __shfl_xor(vss, 32);
                    if (fq == 0) VSSP[(size_t)row * 32 + (u.pn - 8) * 4 + wc] = vss; } }
    }
};
struct EpiRes {
    static constexpr bool PERM = true;
    const float* base; bf16_t* out;
    __device__ __forceinline__ void operator()(const f32x4 (&acc)[2][2][4][2], const Unit& u, int wr, int wc, int fr, int fq) const {
        const int row0 = u.pm * BM + wr * 64 + fr, col0 = u.pn * BM + wc * 32 + 8 * fq;
#pragma unroll
        for (int ai = 0; ai < 2; ++ai)
#pragma unroll
            for (int m = 0; m < 4; ++m) { const size_t off = (size_t)(row0 + ai * HALF + m * 16) * DM + col0;
#pragma unroll
                for (int bj = 0; bj < 2; ++bj) { const f32x4 b0 = *(const f32x4*)(base + off + bj * HALF), b1 = *(const f32x4*)(base + off + bj * HALF + 4);
                    const f32x4 v0 = b0 + acc[ai][bj][m][0], v1 = b1 + acc[ai][bj][m][1];
                    u32x4 w; w.x = cvt_pk_bf16(v0[0], v0[1]); w.y = cvt_pk_bf16(v0[2], v0[3]); w.z = cvt_pk_bf16(v1[0], v1[1]); w.w = cvt_pk_bf16(v1[2], v1[3]);
                    *(u32x4*)(out + off + bj * HALF) = w; } }
    }
};
struct EpiGU {
    static constexpr bool PERM = true;
    bf16_t* HM; const int* list; const float* rstd2;
    __device__ __forceinline__ void operator()(const f32x4 (&acc)[2][2][4][2], const Unit& u, int wr, int wc, int fr, int fq) const {
        const int col0 = u.pn * 128 + wc * 32 + 8 * fq;
#pragma unroll
        for (int ai = 0; ai < 2; ++ai)
#pragma unroll
            for (int m = 0; m < 4; ++m) { const int rt = ai * HALF + wr * 64 + m * 16 + fr;
                if (rt < u.nvalid) {
                    const int a = list[u.e * LISTCAP + u.pm * 256 + rt]; const float rs = rstd2[a >> 1];
                    float h[8];
#pragma unroll
                    for (int n = 0; n < 2; ++n)
#pragma unroll
                        for (int j = 0; j < 4; ++j) { const float g = acc[ai][0][m][n][j] * rs, up = acc[ai][1][m][n][j] * rs; h[n * 4 + j] = g * sigmoid_f(g) * up; }
                    u32x4 w; w.x = cvt_pk_bf16(h[0], h[1]); w.y = cvt_pk_bf16(h[2], h[3]); w.z = cvt_pk_bf16(h[4], h[5]); w.w = cvt_pk_bf16(h[6], h[7]);
                    *(u32x4*)(HM + (size_t)(u.rowbase + rt) * DEXP + col0) = w; } }
    }
};
struct EpiDown {
    static constexpr bool PERM = true;
    bf16_t* YT;
    __device__ __forceinline__ void operator()(const f32x4 (&acc)[2][2][4][2], const Unit& u, int wr, int wc, int fr, int fq) const {
        const int col0 = u.pn * BM + wc * 32 + 8 * fq;
#pragma unroll
        for (int ai = 0; ai < 2; ++ai)
#pragma unroll
            for (int m = 0; m < 4; ++m) { const int rt = ai * HALF + wr * 64 + m * 16 + fr; bf16_t* rowp = YT + (size_t)(u.rowbase + rt) * DM + col0;
                if (rt < u.nvalid) {
#pragma unroll
                for (int bj = 0; bj < 2; ++bj) { const f32x4 v0 = acc[ai][bj][m][0], v1 = acc[ai][bj][m][1];
                    u32x4 w; w.x = cvt_pk_bf16(v0[0], v0[1]); w.y = cvt_pk_bf16(v0[2], v0[3]); w.z = cvt_pk_bf16(v1[0], v1[1]); w.w = cvt_pk_bf16(v1[2], v1[3]);
                    *(u32x4*)(rowp + bj * HALF) = w; } } }
    }
};
}

#define XB_TMO      128
#define XB_XCNT(j)  (256  + 64 * (j))
#define XB_XSUB(j)  (1280 + 64 * (j))
#define XB_XGEN(j)  (2304 + 64 * (j))
#define XB_TOP      3328
#define XB_TOPGEN   3392
#define XCD_BAR_WORDS 3456
#define XB_SPIN_CAP (1u << 18)
__device__ __forceinline__ unsigned xb_ld(unsigned* p)              { return __hip_atomic_load(p, __ATOMIC_RELAXED, __HIP_MEMORY_SCOPE_AGENT); }
__device__ __forceinline__ unsigned xb_add(unsigned* p, unsigned v) { return __hip_atomic_fetch_add(p, v, __ATOMIC_RELAXED, __HIP_MEMORY_SCOPE_AGENT); }
__device__ __forceinline__ unsigned xb_xcc_id() { return (unsigned)__builtin_amdgcn_s_getreg((3 << 11) | 20) & 0xFu; }
#define XB_SPIN(cond, bar) do { unsigned _sp = 0; while (cond) { __builtin_amdgcn_s_sleep(1); \
    if ((++_sp & 255u) == 0u) { if (xb_ld(&(bar)[XB_TMO])) break; if (_sp > XB_SPIN_CAP) { atomicAdd(&(bar)[XB_TMO], 1u); break; } } } } while (0)
struct XcdBarrier { unsigned* bar; unsigned x; volatile LAS unsigned* st; };
__device__ __forceinline__ XcdBarrier xcd_barrier_post(unsigned* bar, volatile LAS unsigned* st) {
    XcdBarrier b; b.bar = bar; b.x = xb_xcc_id(); b.st = st;
    if (threadIdx.x == 0) (void)xb_add(&bar[XB_XCNT(b.x)], 1u);
    return b;
}
__device__ __forceinline__ void xcd_barrier_complete(unsigned* bar, unsigned x, unsigned& nloc, unsigned& nx) {
    const unsigned G = gridDim.x * gridDim.y * gridDim.z;
    unsigned sum, cnt, mine, sp = 0u;
    for (;;) {
        sum = 0u; cnt = 0u; mine = 0u;
#pragma unroll
        for (unsigned j = 0; j < 16; ++j) { const unsigned c = xb_ld(&bar[XB_XCNT(j)]); sum += c; cnt += (c > 0u) ? 1u : 0u; mine = (j == x) ? c : mine; }
        if (sum == G) break;
        __builtin_amdgcn_s_sleep(1);
        if ((++sp & 255u) == 0u) { if (xb_ld(&bar[XB_TMO])) break; if (sp > XB_SPIN_CAP) { atomicAdd(&bar[XB_TMO], 1u); break; } }
    }
    nloc = mine > 0u ? mine : 1u; nx = cnt > 0u ? cnt : 1u;
}
__device__ __forceinline__ void xcd_barrier(const XcdBarrier& b, const bool thread0) {
    asm volatile("s_waitcnt vmcnt(0)" ::: "memory");
    __syncthreads();
    if (thread0) {
        unsigned* bar = b.bar;
        __builtin_amdgcn_s_waitcnt(0);
        unsigned nloc = b.st[0], nx = b.st[1];
        if (nloc == 0u) { xcd_barrier_complete(bar, b.x, nloc, nx); b.st[0] = nloc; b.st[1] = nx; }
        const unsigned old = xb_add(&bar[XB_XSUB(b.x)], 1u);
        const unsigned gen = old / nloc;
        if (old + 1u == (gen + 1u) * nloc) {
            __builtin_amdgcn_fence(__ATOMIC_RELEASE, "agent");
            asm volatile("s_waitcnt vmcnt(0)" ::: "memory");
            const unsigned og = xb_add(&bar[XB_TOP], 1u);
            const unsigned tg = og / nx;
            if (og + 1u == (tg + 1u) * nx) xb_add(&bar[XB_TOPGEN], 1u);
            else XB_SPIN(xb_ld(&bar[XB_TOPGEN]) == tg, bar);
            __builtin_amdgcn_fence(__ATOMIC_ACQUIRE, "agent");
            xb_add(&bar[XB_XGEN(b.x)], 1u);
            asm volatile("s_waitcnt vmcnt(0)" ::: "memory");
        } else {
            XB_SPIN(xb_ld(&bar[XB_XGEN(b.x)]) == gen, bar);
            __builtin_amdgcn_fence(__ATOMIC_ACQUIRE, "agent");
            asm volatile("s_waitcnt vmcnt(0)" ::: "memory");
        }
    }
    __syncthreads();
}

struct Frame {
    LAS unsigned char* lds;
    unsigned* ctl;
    int tid, lane, wave, vcu, G;
    const float *x, *g1, *w_in, *gvn, *gsw, *gsb, *igb, *fgb, *ogn, *w_out, *g2, *rgw, *rgb, *rew, *reb, *wg, *wu, *wd, *gf;
    float* out;
    bf16_t *WIN_T, *WOUT_T, *WGU_T, *WD_T, *WRT, *ACT, *PROJ, *YT, *HM, *QH, *KH, *VH, *PM, *KP;
    float *GATES, *RSTD2, *AW, *HB, *VSSP, *GS; bf16_t* X1; int *LIST, *APOS;
};

struct TrDesc { const float* src; bf16_t* dst; int rk0; int ldw, ldt; };
__device__ __forceinline__ int gain_off(int k) { return (k >> 9) * 16640 + 8448 + 4 * (k & 511); }
__device__ __forceinline__ void tr_load(const TrDesc& d, f32x4 (&v)[16], int lane) {
    const GAS float* wp = (const GAS float*)d.src + (size_t)(lane >> 4) * d.ldw + 4 * (lane & 15);
#pragma unroll
    for (int i = 0; i < 16; ++i) v[i] = __builtin_nontemporal_load((const GAS f32x4*)(wp + (size_t)(4 * i) * d.ldw));
}
__device__ __forceinline__ void tr_store(const TrDesc& d, const f32x4 (&v)[16], LAS float* scr, int lane, LAS unsigned char* lds) {
    LAS unsigned* sw = (LAS unsigned*)scr + (lane >> 4) * 33 + 2 * (lane & 15);
    if (d.rk0 >= 0) { const LAS float* rs = (const LAS float*)(lds + gain_off(d.rk0)) + (lane >> 4);
#pragma unroll
        for (int i = 0; i < 16; ++i) { const float s = rs[4 * i]; sw[(4 * i) * 33 + 0] = cvtpk(v[i].x * s, v[i].y * s); sw[(4 * i) * 33 + 1] = cvtpk(v[i].z * s, v[i].w * s); } }
    else {
#pragma unroll
        for (int i = 0; i < 16; ++i) { sw[(4 * i) * 33 + 0] = cvtpk(v[i].x, v[i].y); sw[(4 * i) * 33 + 1] = cvtpk(v[i].z, v[i].w); } }
    LDS_WAIT();
    const int c = lane & 7;
#pragma unroll
    for (int j = 0; j < 4; ++j) { const int dcol = (lane >> 3) + 8 * j; const LAS unsigned* sr = (const LAS unsigned*)scr + (8 * c) * 33 + dcol;
        unsigned x[8];
#pragma unroll
        for (int kk = 0; kk < 8; ++kk) x[kk] = sr[kk * 33];
        u32x4 lo, hi;
        lo.x = (x[0] & 0xffffu) | (x[1] << 16); lo.y = (x[2] & 0xffffu) | (x[3] << 16); lo.z = (x[4] & 0xffffu) | (x[5] << 16); lo.w = (x[6] & 0xffffu) | (x[7] << 16);
        hi.x = (x[0] >> 16) | (x[1] & 0xffff0000u); hi.y = (x[2] >> 16) | (x[3] & 0xffff0000u); hi.z = (x[4] >> 16) | (x[5] & 0xffff0000u); hi.w = (x[6] >> 16) | (x[7] & 0xffff0000u);
        GAS bf16_t* op = (GAS bf16_t*)d.dst + (size_t)(2 * dcol) * d.ldt + 8 * c;
        __builtin_nontemporal_store(lo, (GAS u32x4*)op); __builtin_nontemporal_store(hi, (GAS u32x4*)(op + d.ldt)); }
    LDS_WAIT();
}
__device__ __forceinline__ void phase0(Frame& F) {
    LAS float* gwl = (LAS float*)F.lds;
    { f32x4 wv[16]; float gv[16];
#pragma unroll
      for (int i = 0; i < 16; ++i) { const int p = F.tid + 512 * i, k = p >> 1; wv[i] = *(const f32x4*)(F.w_in + (size_t)k * LDW_IN + NPROJ + 4 * (p & 1)); gv[i] = F.g1[k]; }
#pragma unroll
      for (int i = 0; i < 16; ++i) { const int p = F.tid + 512 * i, k = p >> 1, j0 = 4 * (p & 1);
          gwl[(j0 + 0) * 4096 + k] = gv[i] * wv[i].x; gwl[(j0 + 1) * 4096 + k] = gv[i] * wv[i].y; gwl[(j0 + 2) * 4096 + k] = gv[i] * wv[i].z; gwl[(j0 + 3) * 4096 + k] = gv[i] * wv[i].w; } }
    __syncthreads();
    const int gw = F.vcu * 8 + F.wave, NGW = F.G * 8;
    for (int m = gw; m < NTOK; m += NGW) {
        const f32x4* xr = (const f32x4*)(F.x + (size_t)m * DM) + F.lane;
        const f32x4* gr = (const f32x4*)F.g1 + F.lane;
        asm volatile("" : "+v"(gr));
        f32x4 v[16];
#pragma unroll
        for (int j = 0; j < 16; ++j) v[j] = xr[64 * j];
        const LAS float* l0 = gwl + 4 * F.lane; const LAS float* l1 = l0 + 4 * 4096;
        asm volatile("" : "+v"(l0), "+v"(l1));
        float ss = 0.f; float ga[8];
#pragma unroll
        for (int c = 0; c < 8; ++c) ga[c] = 0.f;
#pragma unroll
        for (int j = 0; j < 16; ++j) { const f32x4 y = v[j]; ss += (y.x * y.x + y.y * y.y) + (y.z * y.z + y.w * y.w);
#pragma unroll
            for (int c = 0; c < 4; ++c) { const f32x4 w = *(const LAS f32x4*)(l0 + 256 * j + c * 4096); ga[c] += (y.x * w.x + y.y * w.y) + (y.z * w.z + y.w * w.w); }
#pragma unroll
            for (int c = 0; c < 4; ++c) { const f32x4 w = *(const LAS f32x4*)(l1 + 256 * j + c * 4096); ga[4 + c] += (y.x * w.x + y.y * w.y) + (y.z * w.z + y.w * w.w); }
            }
        ss = wave_sum(ss);
        const float rstd = 1.0f / sqrtf(ss * (1.0f / DM) + EPS);
#pragma unroll
        for (int c = 0; c < 8; ++c) ga[c] = wave_sum(ga[c]) * rstd;
        if (F.lane == 0) { f32x4* gp = (f32x4*)(F.GATES + (size_t)m * 8); gp[0] = (f32x4){ga[0], ga[1], ga[2], ga[3]}; gp[1] = (f32x4){ga[4], ga[5], ga[6], ga[7]}; }
        u32x2* o8 = (u32x2*)(F.ACT + (size_t)m * DM) + F.lane;
#pragma unroll
        for (int j = 0; j < 16; ++j) { const f32x4 y = v[j] * rstd * gr[64 * j]; u32x2 o; o.x = cvtpk(y.x, y.y); o.y = cvtpk(y.z, y.w); o8[64 * j] = o; }
    }
    __syncthreads();
}
constexpr int I_IN = 64 * 160, I_OUT = 64 * 64, I_G = 64 * 512, I_U = I_G, I_D = 64 * 512;
constexpr int NITEMS = I_IN + I_OUT + I_G + I_U + I_D, ITEMS_DENSE = I_IN;
constexpr int NCONV = 72;
__device__ __forceinline__ void phase_convert(Frame& F, const int it_lo, const int it_hi, const int gw, const int NGW) {
    LAS float* scr = (LAS float*)(F.lds + F.wave * 16640);
    if (it_hi > ITEMS_DENSE + I_OUT) { __syncthreads(); for (int k = F.tid; k < DM; k += 512) *(LAS float*)(F.lds + gain_off(k)) = F.g2[k]; __syncthreads(); }
    auto decode = [&](int it) -> TrDesc {
        TrDesc d; int r = it;
        if (r < I_IN) { const int kb = r & 63, nb = r >> 6;   d.src = F.w_in + (size_t)(64 * kb) * LDW_IN + 64 * nb; d.rk0 = -1; d.ldw = LDW_IN; d.dst = F.WIN_T + (size_t)(64 * nb) * DM + 64 * kb; d.ldt = DM; return d; } r -= I_IN;
        if (r < I_OUT) { const int kb = r & 63, nb = r >> 6; d.src = F.w_out + (size_t)(64 * kb) * DM + 64 * nb; d.rk0 = -1; d.ldw = DM; d.dst = F.WOUT_T + (size_t)(64 * nb) * DM + 64 * kb; d.ldt = DM; return d; } r -= I_OUT;
        if (r < I_G + I_U) { const int up = (r >= I_G) ? 1 : 0; r -= up * I_G; const int e = r >> 9, q = r & 511, kb = (q >> 6) * 8 + (q & 7), n0 = ((q >> 3) & 7) * 64; const int drow = (n0 >> 7) * 256 + up * 128 + (n0 & 127);
            d.src = (up ? F.wu : F.wg) + (size_t)e * DM * DEXP + (size_t)(64 * kb) * DEXP + n0; d.rk0 = 64 * kb; d.ldw = DEXP; d.dst = F.WGU_T + (size_t)e * 1024 * DM + (size_t)drow * DM + 64 * kb; d.ldt = DM; return d; } r -= I_G + I_U;
        { const int e = r >> 9, q = r & 511, kb = q & 7, nb = q >> 3;
            d.src = F.wd + (size_t)e * DEXP * DM + (size_t)(64 * kb) * DM + 64 * nb; d.rk0 = -1; d.ldw = DM; d.dst = F.WD_T + (size_t)e * DM * DEXP + (size_t)(64 * nb) * DEXP + 64 * kb; d.ldt = DEXP; return d; }
    };
    if (NGW < 0) {
        const int per = (it_hi - it_lo + (-NGW) - 1) / (-NGW); int it = it_lo + gw * per; const int ie = (it + per < it_hi) ? it + per : it_hi;
        f32x4 va[16], vb[16], vc[16]; TrDesc da, db, dc;
        if (it < ie) { da = decode(it); tr_load(da, va, F.lane); }
        if (it + 1 < ie) { db = decode(it + 1); tr_load(db, vb, F.lane); }
        for (; it < ie; it += 3) {
            if (it + 2 < ie) { dc = decode(it + 2); tr_load(dc, vc, F.lane); }
            tr_store(da, va, scr, F.lane, F.lds);
            if (it + 1 >= ie) break;
            if (it + 3 < ie) { da = decode(it + 3); tr_load(da, va, F.lane); }
            tr_store(db, vb, scr, F.lane, F.lds);
            if (it + 2 >= ie) break;
            if (it + 4 < ie) { db = decode(it + 4); tr_load(db, vb, F.lane); }
            tr_store(dc, vc, scr, F.lane, F.lds);
        }
        return; }
    { f32x4 va[16], vb[16]; TrDesc d0, d1; int it = it_lo + gw;
      if (it < it_hi) { d0 = decode(it); tr_load(d0, va, F.lane); }
      for (; it < it_hi; it += NGW) {
          const bool has = (it + NGW) < it_hi;
          if (has) { d1 = decode(it + NGW); tr_load(d1, vb, F.lane); }
          tr_store(d0, va, scr, F.lane, F.lds);
          if (has) { d0 = d1;
#pragma unroll
              for (int i = 0; i < 16; ++i) va[i] = vb[i]; }
      } }
}
__device__ __forceinline__ void phase0b(Frame& F) {
    phase_convert(F, 0, ITEMS_DENSE, F.vcu * 8 + F.wave, F.G * 8);
#pragma unroll 2
    for (int idx = F.vcu * 512 + F.tid; idx < 80 * 4096; idx += F.G * 512) { const int n = idx >> 12, k = idx & 4095;
        const float v = (n < 8) ? F.rgw[k * 8 + n] : ((n < 72) ? F.rew[k * 64 + (n - 8)] : 0.f); F.WRT[idx] = (bf16_t)f2bf(v * F.g2[k]); }
}

typedef short v4i16_t __attribute__((ext_vector_type(4)));
__device__ __forceinline__ bf16x8 tr_bfrag(const LAS bf16_t* p0, const LAS bf16_t* p1) {
    const v4i16_t a = __builtin_amdgcn_ds_read_tr16_b64_v4i16((LAS v4i16_t*)p0), b = __builtin_amdgcn_ds_read_tr16_b64_v4i16((LAS v4i16_t*)p1);
    bf16x8 o; o[0] = a[0]; o[1] = a[1]; o[2] = a[2]; o[3] = a[3]; o[4] = b[0]; o[5] = b[1]; o[6] = b[2]; o[7] = b[3]; return o;
}
__device__ __forceinline__ void phase_gmlp(Frame& F) {
    LAS bf16_t* Wl = (LAS bf16_t*)(F.lds);
    LAS bf16_t* VT = (LAS bf16_t*)(F.lds + 34816);
    LAS float* rs = (LAS float*)(F.lds + 69632);
    LAS float* Zt = (LAS float*)(F.lds + 70144);
    const int r = F.lane & 15, g4 = F.lane >> 4;
    for (int unit = blockIdx.x; unit < 512; unit += F.G) {
        const int g = unit & 15, cb = unit >> 4;
#pragma unroll
        for (int i = 0; i < 8; ++i) { const int idx = F.tid + 512 * i, t = idx >> 5, sc = (idx & 31) * 4;
            f32x4 w = *(const f32x4*)(F.gsw + (size_t)g * 16384 + t * 128 + sc);
            w.x = (sc + 0 <= t) ? w.x : 0.f; w.y = (sc + 1 <= t) ? w.y : 0.f; w.z = (sc + 2 <= t) ? w.z : 0.f; w.w = (sc + 3 <= t) ? w.w : 0.f;
            u32x2 o; o.x = cvtpk(w.x, w.y); o.y = cvtpk(w.z, w.w); *(LAS u32x2*)(Wl + t * 136 + sc) = o; }
        u32x4 vraw[4], uraw[4]; f32x4 pp[8];
#define GM_PREFETCH_V(chn) do { const int r0n = (4 * cb + (chn)) * 128; \
            _Pragma("unroll") for (int i = 0; i < 4; ++i) { const int idx_ = F.tid + 512 * i; vraw[i] = *(const u32x4*)(F.PROJ + (size_t)(r0n + (idx_ >> 4)) * NPROJ + C_V + g * 128 + (idx_ & 15) * 8); } \
            if (F.tid < 128) { const f32x4* pq = (const f32x4*)(F.VSSP + (size_t)(r0n + F.tid) * 32); _Pragma("unroll") for (int q = 0; q < 8; ++q) pp[q] = pq[q]; } } while (0)
        GM_PREFETCH_V(0);
        LDS_BARRIER();
#pragma unroll
        for (int ch = 0; ch < 4; ++ch) {
            const int r0 = (4 * cb + ch) * 128;
            if (F.tid < 128) { float ss = 0.f;
#pragma unroll
                for (int q = 0; q < 8; ++q) ss += (pp[q].x + pp[q].y) + (pp[q].z + pp[q].w);
                rs[F.tid] = 1.0f / sqrtf(ss * (1.0f / 2048.0f) + EPS); }
            LDS_BARRIER();
            { const int d8 = (F.tid & 15) * 8;
              const f32x4 gva = *(const f32x4*)(F.gvn + g * 128 + d8), gvb = *(const f32x4*)(F.gvn + g * 128 + d8 + 4);
#pragma unroll
              for (int i = 0; i < 4; ++i) { const int t = (F.tid >> 4) + 32 * i; const float scl = rs[t];
                const u32x4 raw = vraw[i]; const f32x4 ga = gva * scl, gb = gvb * scl;
                u32x4 o; o.x = cvtpk(bf_lo(raw.x) * ga.x, bf_hi(raw.x) * ga.y); o.y = cvtpk(bf_lo(raw.y) * ga.z, bf_hi(raw.y) * ga.w); o.z = cvtpk(bf_lo(raw.z) * gb.x, bf_hi(raw.z) * gb.y); o.w = cvtpk(bf_lo(raw.w) * gb.z, bf_hi(raw.w) * gb.w);
                *(LAS u32x4*)(VT + t * 136 + d8) = o; } }
#pragma unroll
            for (int i = 0; i < 4; ++i) { const int idx = F.tid + 512 * i; uraw[i] = *(const u32x4*)(F.PROJ + (size_t)(r0 + (idx >> 4)) * NPROJ + C_U + g * 128 + (idx & 15) * 8); }
            if (ch + 1 < 4) GM_PREFETCH_V(ch + 1);
            LDS_BARRIER();
            const int t0 = 16 * F.wave, nks = (F.wave >> 1) + 1;
            f32x4 acc[8];
#pragma unroll
            for (int dt = 0; dt < 8; ++dt) acc[dt] = (f32x4){0.f, 0.f, 0.f, 0.f};
            for (int ks = 0; ks < nks; ++ks) {
                const bf16x8 A = *(const LAS bf16x8*)(Wl + (t0 + r) * 136 + 32 * ks + 8 * g4);
                bf16x8 B[8];
#pragma unroll
                for (int dt = 0; dt < 8; ++dt) { const LAS bf16_t* bp = VT + (32 * ks + 8 * g4 + (r >> 2)) * 136 + 16 * dt + 4 * (r & 3); B[dt] = tr_bfrag(bp, bp + 4 * 136); }
                __builtin_amdgcn_sched_barrier(0);
#pragma unroll
                for (int dt = 0; dt < 8; ++dt) acc[dt] = mfma16(A, B[dt], acc[dt]);
                __builtin_amdgcn_sched_barrier(0); }
#pragma unroll
            for (int rr = 0; rr < 4; ++rr) { const int t = t0 + 4 * g4 + rr; const float bias = F.gsb[g * 128 + t];
#pragma unroll
                for (int dt = 0; dt < 8; ++dt) Zt[t * 132 + 16 * dt + r] = acc[dt][rr] + bias; }
            LDS_BARRIER();
#pragma unroll
            for (int i = 0; i < 4; ++i) { const int idx = F.tid + 512 * i, t = idx >> 4, d8 = (idx & 15) * 8;
                const u32x4 uu = uraw[i];
                const f32x4 z0 = *(const LAS f32x4*)(Zt + t * 132 + d8), z1 = *(const LAS f32x4*)(Zt + t * 132 + d8 + 4);
                u32x4 o; o.x = cvtpk(bf_lo(uu.x) * z0.x, bf_hi(uu.x) * z0.y); o.y = cvtpk(bf_lo(uu.y) * z0.z, bf_hi(uu.y) * z0.w); o.z = cvtpk(bf_lo(uu.z) * z1.x, bf_hi(uu.z) * z1.y); o.w = cvtpk(bf_lo(uu.w) * z1.z, bf_hi(uu.w) * z1.w);
                *(u32x4*)(F.ACT + (size_t)(r0 + t) * DM + g * 128 + d8) = o; }
        }
#undef GM_PREFETCH_V
        __syncthreads();
    }
}

__device__ __forceinline__ float softcap15(float z) { return 15.0f * tanhf(z * (1.0f / 15.0f)); }
__device__ __forceinline__ void phase_gates(Frame& F, const int bh) {
    LAS float* SA = (LAS float*)(F.lds);
    LAS float* SM = (LAS float*)(F.lds + 16384);
    LAS float* SFL = (LAS float*)(F.lds + 32768);
    LAS float* scr = (LAS float*)(F.lds + 134144);
    const int tid = F.tid, lane = F.lane, wave = F.wave, b = bh >> 2, hh = bh & 3, rowb = b * SEQL;
    __syncthreads();
        { const float igb = F.igb[hh], fgb = F.fgb[hh];
          float cs[8], av[8]; float run = 0.f;
          float gi8[8], gf8[8];
#pragma unroll
          for (int k = 0; k < 8; ++k) { const float* gp = F.GATES + (size_t)(rowb + 8 * tid + k) * 8; gi8[k] = gp[hh]; gf8[k] = gp[4 + hh]; }
#pragma unroll
          for (int k = 0; k < 8; ++k) { const float zf = softcap15(gf8[k] + fgb); run += -log1pf(expf(-zf)); cs[k] = run; av[k] = softcap15(gi8[k] + igb); }
          float incl = run;
#pragma unroll
          for (int o = 1; o < 64; o <<= 1) { const float t = __shfl_up(incl, o); if (lane >= o) incl += t; }
          if (lane == 63) scr[wave] = incl;
          __syncthreads();
          float base = incl - run;
          for (int w = 0; w < wave; ++w) base += scr[w];
          float Bv[8]; float runm = -3.0e38f; float mx[8];
#pragma unroll
          for (int k = 0; k < 8; ++k) { Bv[k] = base + cs[k]; av[k] = av[k] - Bv[k]; runm = fmaxf(runm, av[k]); mx[k] = runm; }
          float inclm = runm;
#pragma unroll
          for (int o = 1; o < 64; o <<= 1) { const float t = __shfl_up(inclm, o); if (lane >= o) inclm = fmaxf(inclm, t); }
          float exclm = __shfl_up(inclm, 1); if (lane == 0) exclm = -3.0e38f;
          if (lane == 63) scr[8 + wave] = inclm;
          __syncthreads();
          float basem = fmaxf(0.f, exclm);
          for (int w = 0; w < wave; ++w) basem = fmaxf(basem, scr[8 + w]);
          float Mv[8], flv[8];
#pragma unroll
          for (int k = 0; k < 8; ++k) { Mv[k] = fmaxf(basem, mx[k]); flv[k] = expf(-(Bv[k] + Mv[k])); }
          *(LAS f32x4*)(SA + 8 * tid) = (f32x4){av[0], av[1], av[2], av[3]}; *(LAS f32x4*)(SA + 8 * tid + 4) = (f32x4){av[4], av[5], av[6], av[7]};
          *(LAS f32x4*)(SM + 8 * tid) = (f32x4){Mv[0], Mv[1], Mv[2], Mv[3]}; *(LAS f32x4*)(SM + 8 * tid + 4) = (f32x4){Mv[4], Mv[5], Mv[6], Mv[7]};
          *(LAS f32x4*)(SFL + 8 * tid) = (f32x4){flv[0], flv[1], flv[2], flv[3]}; *(LAS f32x4*)(SFL + 8 * tid + 4) = (f32x4){flv[4], flv[5], flv[6], flv[7]}; }
    __syncthreads();
    { f32x4* gs = (f32x4*)(F.GS + (size_t)bh * 3 * 4096);
#pragma unroll
      for (int i = 0; i < 6; ++i) gs[tid + 512 * i] = *(const LAS f32x4*)(SA + 4 * (tid + 512 * i)); }
    __syncthreads();
}
__device__ __forceinline__ void phase_mlstm_pre(Frame& F) {
    LAS bf16_t* Kc = (LAS bf16_t*)(F.lds);
    LAS bf16_t* Qc = (LAS bf16_t*)(F.lds + 67584);
    const int wave = F.wave, pp = (wave < 4) ? wave : 7 - wave, hi = wave >> 2;
    for (int unit = F.vcu; unit < 256; unit += F.G) {
        const int bh = unit >> 4, es = unit & 15;
        int ln_ = F.lane; asm volatile("" : "+v"(ln_));
        const int r = ln_ & 15, g4 = ln_ >> 4, tid = wave * 64 + ln_;
        const float* ga = F.GS + (size_t)bh * 3 * 4096; const float* gm = ga + 4096;
        u32x4 kreg[8], qreg[8];
#define MP_LOAD(c) do { const char* kb_ = (const char*)(F.KH + (size_t)bh * SEQL * 256) + (size_t)(c) * 65536; const char* qb_ = (const char*)(F.QH + (size_t)bh * SEQL * 256) + (size_t)(c) * 65536; \
        _Pragma("unroll") for (int i = 0; i < 8; ++i) { kreg[i] = *(const u32x4*)(kb_ + 8192 * i + 16u * (unsigned)tid); qreg[i] = *(const u32x4*)(qb_ + 8192 * i + 16u * (unsigned)tid); } } while (0)
        MP_LOAD(es * 2);
        for (int t = 0; t < 2; ++t) {
            const int c = es * 2 + t, pb = 128 * c;
            char* kp_ = (char*)(F.KP + (size_t)bh * SEQL * 256) + (size_t)c * 65536;
            const float Mend = gm[pb + 127];
            __syncthreads();
#pragma unroll
            for (int i = 0; i < 8; ++i) { const int rowo = 16 * i;
                *(LAS u32x4*)(Kc + (tid >> 5) * 264 + 8 * (tid & 31) + rowo * 264) = kreg[i]; *(LAS u32x4*)(Qc + (tid >> 5) * 264 + 8 * (tid & 31) + rowo * 264) = qreg[i];
                const float wt = fast_exp(ga[pb + (tid >> 5) + rowo] - Mend); u32x4 kw;
                kw.x = cvtpk(bf_lo(kreg[i].x) * wt, bf_hi(kreg[i].x) * wt); kw.y = cvtpk(bf_lo(kreg[i].y) * wt, bf_hi(kreg[i].y) * wt); kw.z = cvtpk(bf_lo(kreg[i].z) * wt, bf_hi(kreg[i].z) * wt); kw.w = cvtpk(bf_lo(kreg[i].w) * wt, bf_hi(kreg[i].w) * wt);
                *(u32x4*)(kp_ + 8192 * i + 16u * (unsigned)tid) = kw; }
            LDS_BARRIER();
            if (t == 0) MP_LOAD(c + 1);
#pragma unroll
            for (int part = 0; part < 2; ++part) {
                const int rt = part ? 7 - pp : pp;
                const int jlo = part ? (hi ? 4 - pp : 0) : 0, jhi = part ? (hi ? 7 - pp : 3 - pp) : (hi ? -1 : pp);
                if (jlo <= jhi) {
                    const int i0 = 16 * rt;
                    bf16x8 Qf[8];
#pragma unroll
                    for (int ks = 0; ks < 8; ++ks) Qf[ks] = *(const LAS bf16x8*)(Qc + (i0 + r) * 264 + 32 * ks + 8 * g4);
                    bf16_t* Pg = F.PM + ((size_t)bh * 32 + c) * 16384 + (size_t)(i0 + r) * 128 + 4 * g4;
                    const float Mi = gm[pb + i0 + r]; const int irow = i0 + r;
                    for (int jt = jlo; jt <= jhi; ++jt) {
                        bf16x8 Kf[8];
#pragma unroll
                        for (int ks = 0; ks < 8; ++ks) Kf[ks] = *(const LAS bf16x8*)(Kc + (16 * jt + r) * 264 + 32 * ks + 8 * g4);
                        const f32x4 a4 = *(const f32x4*)(ga + pb + 16 * jt + 4 * g4);
                        __builtin_amdgcn_sched_barrier(0);
                        f32x4 sv = (f32x4){0.f, 0.f, 0.f, 0.f};
#pragma unroll
                        for (int ks = 0; ks < 8; ++ks) sv = mfma16(Kf[ks], Qf[ks], sv);
                        __builtin_amdgcn_sched_barrier(0);
                        float p[4];
#pragma unroll
                        for (int rr = 0; rr < 4; ++rr) p[rr] = (16 * jt + 4 * g4 + rr <= irow) ? sv[rr] * fast_exp(a4[rr] - Mi) : 0.f;
                        u32x2 w; w.x = cvtpk(p[0], p[1]); w.y = cvtpk(p[2], p[3]);
                        *(u32x2*)(Pg + 16 * jt) = w; }
                    if (jhi == rt && (rt & 1) == 0) *(u32x2*)(Pg + 16 * (rt + 1)) = (u32x2){0u, 0u};
                } }
        }
#undef MP_LOAD
    }
    __syncthreads();
}
__device__ __forceinline__ void phase_mlstm(Frame& F) {
    LAS float* SM = (LAS float*)(F.lds);
    LAS float* SFL = (LAS float*)(F.lds + 16384);
    LAS bf16_t* Kc = (LAS bf16_t*)(F.lds + 32768);
    LAS bf16_t* CT = (LAS bf16_t*)(F.lds + 100352);
    LAS bf16_t* NV = (LAS bf16_t*)(F.lds + 117248);
    LAS bf16_t* Vc = (LAS bf16_t*)(F.lds + 117760);
    const int wave = F.wave;
    const int rt = (wave < 4) ? wave : 11 - wave, i0 = 16 * rt, nks = (rt >> 1) + 1, et = wave >> 2, dq = wave & 3;
    for (int unit = F.vcu; unit < 256; unit += F.G) {
        const int b = unit >> 6, hh = (unit >> 4) & 3, es = unit & 15, e0 = es * 32, bh = b * 4 + hh;
        const int rowb = b * SEQL;
        int ln_ = F.lane; asm volatile("" : "+v"(ln_));
        const int r = ln_ & 15, g4 = ln_ >> 4, tid = wave * 64 + ln_;
        __syncthreads();
        { const f32x4* gs = (const f32x4*)(F.GS + (size_t)bh * 3 * 4096 + 4096);
#pragma unroll
          for (int i = 0; i < 4; ++i) *(LAS f32x4*)(SM + 4 * (tid + 512 * i)) = gs[tid + 512 * i]; }
        for (int idx = tid; idx < 32 * 264; idx += 512) CT[idx] = 0;
        if (tid < 256) NV[tid] = 0;
        __syncthreads();
        const char* Kp = (const char*)(F.KP + (size_t)bh * SEQL * 256); const unsigned kvo = 16u * (unsigned)tid;
        const char* Vp = (const char*)(F.VH + (size_t)bh * SEQL * 512 + e0); const unsigned vvo = (unsigned)((tid >> 2) * 1024 + (tid & 3) * 16);
        const char* Qp = (const char*)(F.QH + (size_t)bh * SEQL * 256) + i0 * 512; const unsigned qvo = (unsigned)(r * 512 + 16 * g4);
        const char* Pp = (const char*)(F.PM + (size_t)bh * 32 * 16384) + i0 * 256; const unsigned pvo = (unsigned)(r * 256 + 16 * g4);
        f32x4 accC[4], accN[4];
#pragma unroll
        for (int dd = 0; dd < 4; ++dd) { accC[dd] = (f32x4){0.f, 0.f, 0.f, 0.f}; accN[dd] = (f32x4){0.f, 0.f, 0.f, 0.f}; }
        u32x4 kreg[8], vreg, Qr[8], Pr[4];
#pragma unroll
        for (int ks = 0; ks < 4; ++ks) Pr[ks] = (u32x4){0u, 0u, 0u, 0u};
#define ML_LOADKV(c) do { const char* kb_ = Kp + (size_t)(c) * 65536; _Pragma("unroll") for (int i = 0; i < 8; ++i) kreg[i] = *(const u32x4*)(kb_ + 8192 * i + kvo); vreg = *(const u32x4*)(Vp + (size_t)(c) * 131072 + vvo); } while (0)
#define ML_LOADQ(c) do { const char* qb_ = Qp + (size_t)(c) * 65536; _Pragma("unroll") for (int ks = 0; ks < 8; ++ks) Qr[ks] = *(const u32x4*)(qb_ + 64 * ks + qvo); } while (0)
#define ML_LOADP(c) do { const char* pb_ = Pp + (size_t)(c) * 32768; _Pragma("unroll") for (int ks = 0; ks < 4; ++ks) if (ks < nks) Pr[ks] = *(const u32x4*)(pb_ + 64 * ks + pvo); } while (0)
        ML_LOADKV(0); ML_LOADQ(0); ML_LOADP(0);
        __builtin_amdgcn_s_waitcnt(0);
        for (int c = 0; c < 32; ++c) {
            const int pb = 128 * c;
#pragma unroll
            for (int i = 0; i < 8; ++i) *(LAS u32x4*)(Kc + (tid >> 5) * 264 + 8 * (tid & 31) + i * (16 * 264)) = kreg[i];
            *(LAS u32x4*)(Vc + (tid >> 2) * 48 + 8 * (tid & 3)) = vreg;
            LDS_BARRIER();
            if (c + 1 < 32) { ML_LOADKV(c + 1); }
            const float Rc = (c == 0) ? 0.f : SM[pb - 1]; const float Rn = SM[pb + 127]; const float decay = fast_exp(Rc - Rn);
            const bf16x8 ones = (bf16x8){(short)0x3f80, (short)0x3f80, (short)0x3f80, (short)0x3f80, (short)0x3f80, (short)0x3f80, (short)0x3f80, (short)0x3f80};
            {
#pragma unroll
              for (int dd = 0; dd < 4; ++dd) { accC[dd] = accC[dd] * decay; accN[dd] = accN[dd] * decay; }
#pragma unroll
              for (int ks = 0; ks < 4; ++ks) { bf16x8 Kb[4];
                  const LAS bf16_t* wp = Vc + (32 * ks + 8 * g4 + (r >> 2)) * 48 + 16 * et + 4 * (r & 3); const bf16x8 Aw = tr_bfrag(wp, wp + 4 * 48);
                  const LAS bf16_t* kp = Kc + (32 * ks + 8 * g4 + (r >> 2)) * 264 + 64 * dq + 4 * (r & 3);
#pragma unroll
                  for (int dd = 0; dd < 4; ++dd) Kb[dd] = tr_bfrag(kp + 16 * dd, kp + 4 * 264 + 16 * dd);
#pragma unroll
                  for (int dd = 0; dd < 4; ++dd) accC[dd] = mfma16(Kb[dd], Aw, accC[dd]);
                  if (et == 0) {
#pragma unroll
                      for (int dd = 0; dd < 4; ++dd) accN[dd] = mfma16(Kb[dd], ones, accN[dd]); } }
            }
            __builtin_amdgcn_sched_barrier(0);
            bf16x8 R[8];
#pragma unroll
            for (int ks = 0; ks < 8; ++ks) R[ks] = *(const LAS bf16x8*)(CT + r * 264 + 32 * ks + 8 * g4);
            f32x4 o1a = (f32x4){0.f, 0.f, 0.f, 0.f}, o1b = o1a, o2a = o1a, o2b = o1a, qn = o1a, dsum = o1a;
            __builtin_amdgcn_sched_barrier(0);
#define ML_SEG(MF, NEXTREAD) do { _Pragma("unroll") for (int ks = 0; ks < 8; ++ks) { MF; NEXTREAD; __builtin_amdgcn_sched_barrier(0); } } while (0)
            ML_SEG(o2a = mfma16(__builtin_bit_cast(bf16x8, Qr[ks]), R[ks], o2a), R[ks] = *(const LAS bf16x8*)(CT + (16 + r) * 264 + 32 * ks + 8 * g4));
            ML_SEG(o2b = mfma16(__builtin_bit_cast(bf16x8, Qr[ks]), R[ks], o2b), R[ks] = *(const LAS bf16x8*)(NV + 32 * ks + 8 * g4));
            { const LAS bf16_t* vp = Vc + (8 * g4 + (r >> 2)) * 48 + 4 * (r & 3);
#pragma unroll
              for (int ks = 0; ks < 4; ++ks) if (ks < nks) { const bf16x8 Ap = __builtin_bit_cast(bf16x8, Pr[ks]);
                  const bf16x8 Bva = tr_bfrag(vp + 32 * ks * 48, vp + (32 * ks + 4) * 48), Bvb = tr_bfrag(vp + 32 * ks * 48 + 16, vp + (32 * ks + 4) * 48 + 16);
                  o1a = mfma16(Ap, Bva, o1a); o1b = mfma16(Ap, Bvb, o1b); dsum = mfma16(Ap, ones, dsum); } }
            __builtin_amdgcn_sched_barrier(0);
            if (c + 1 < 32) { ML_LOADP(c + 1); }
            ML_SEG(qn = mfma16(__builtin_bit_cast(bf16x8, Qr[ks]), R[ks], qn), (void)0);
#undef ML_SEG
            __builtin_amdgcn_sched_barrier(0);
            if (c + 1 < 32) { ML_LOADQ(c + 1); }
            { const f32x4 Mi4 = *(const LAS f32x4*)(SM + pb + i0 + 4 * g4), fl4 = *(const LAS f32x4*)(SFL + pb + i0 + 4 * g4);
              char* hb_ = (char*)(F.HB + (size_t)(rowb + pb + i0) * 2048 + hh * 512 + e0); const unsigned hvoff = (unsigned)(4 * g4) * 8192u + 4u * (unsigned)r;
#pragma unroll
              for (int rr = 0; rr < 4; ++rr) { const float wir = fast_exp(Rc - Mi4[rr]);
                  const float den = wir * qn[rr] + dsum[rr]; const float inv = __builtin_amdgcn_rcpf(fmaxf(fabsf(den), fl4[rr]));
                  *(float*)(hb_ + (hvoff + 8192u * rr)) = (o1a[rr] + wir * o2a[rr]) * inv; *(float*)(hb_ + (hvoff + 8192u * rr) + 64) = (o1b[rr] + wir * o2b[rr]) * inv; } }
            {
              LDS_BARRIER();
#pragma unroll
              for (int dd = 0; dd < 4; ++dd) { u32x2 cw; cw.x = cvtpk(accC[dd][0], accC[dd][1]); cw.y = cvtpk(accC[dd][2], accC[dd][3]);
                  *(LAS u32x2*)(CT + (16 * et + r) * 264 + 16 * (4 * dq + dd) + 4 * g4) = cw; }
              if (et == 0 && r == 0) {
#pragma unroll
                  for (int dd = 0; dd < 4; ++dd) { u32x2 nw; nw.x = cvtpk(accN[dd][0], accN[dd][1]); nw.y = cvtpk(accN[dd][2], accN[dd][3]); *(LAS u32x2*)(NV + 16 * (4 * dq + dd) + 4 * g4) = nw; } } }
        }
#undef ML_LOADKV
#undef ML_LOADQ
#undef ML_LOADP
        __syncthreads();
    }
}
__device__ __forceinline__ void phase_mlnorm(Frame& F) {
    const int gw = F.vcu * 8 + F.wave, NGW = F.G * 8;
    for (int m = gw; m < NTOK; m += NGW) {
#pragma unroll
        for (int hh = 0; hh < 4; ++hh) {
            const f32x4* hp = (const f32x4*)(F.HB + (size_t)m * 2048 + hh * 512) + F.lane;
            const f32x4 v0 = hp[0], v1 = hp[64];
            float ss = (v0.x * v0.x + v0.y * v0.y) + (v0.z * v0.z + v0.w * v0.w) + (v1.x * v1.x + v1.y * v1.y) + (v1.z * v1.z + v1.w * v1.w);
            ss = wave_sum(ss);
            const float rstd = 1.0f / sqrtf(ss * (1.0f / 512.0f) + EPS);
            const f32x4* gp = (const f32x4*)(F.ogn + hh * 512) + F.lane; const f32x4 g0 = gp[0], g1 = gp[64];
            const u32x2* op = (const u32x2*)(F.PROJ + (size_t)m * NPROJ + C_O + hh * 512) + F.lane; const u32x2 s0 = op[0], s1 = op[64];
            u32x2* yp = (u32x2*)(F.ACT + (size_t)m * DM + 2048 + hh * 512) + F.lane;
            u32x2 o;
            o.x = pk2(v0.x * rstd * g0.x * bf_lo(s0.x), v0.y * rstd * g0.y * bf_hi(s0.x)); o.y = pk2(v0.z * rstd * g0.z * bf_lo(s0.y), v0.w * rstd * g0.w * bf_hi(s0.y)); yp[0] = o;
            o.x = pk2(v1.x * rstd * g1.x * bf_lo(s1.x), v1.y * rstd * g1.y * bf_hi(s1.x)); o.y = pk2(v1.z * rstd * g1.z * bf_lo(s1.y), v1.w * rstd * g1.w * bf_hi(s1.y)); yp[64] = o;
        }
    }
}

__device__ __forceinline__ void phase_router(Frame& F) {
    const int lane = F.lane, tid = F.tid, r = lane & 15, g4 = lane >> 4, pair = F.wave >> 1, half = F.wave & 1;
    LAS unsigned char* Bb = F.lds;
    LAS float* lg = (LAS float*)(F.lds + 40960) + F.wave * (16 * 81 + 16);
    for (int task = F.vcu * 4 + pair; task < NTOK / 16; task += F.G * 4) {
        const int row0 = task * 16;
        const bf16_t* xrow = F.X1 + (size_t)(row0 + r) * DM + half * 64 + 8 * g4;
        const int rotc = (F.vcu * 5) & 31;
        f32x4 acc[5];
#pragma unroll
        for (int nt = 0; nt < 5; ++nt) acc[nt] = (f32x4){0.f, 0.f, 0.f, 0.f};
        float ss = 0.f;
        u32x4 bst[3], x0[2], x1[2], x2[2], x3[2];
#define RT_KC(cc) (((cc) + rotc) & 31)
#define RT_BLOAD(cc) do { const bf16_t* wp_ = F.WRT + (size_t)RT_KC(cc) * 128; _Pragma("unroll") for (int q = 0; q < 3; ++q) { const int gc = tid + 512 * q; \
            if (gc < 1280) bst[q] = *(const u32x4*)(wp_ + (size_t)(gc >> 4) * DM + (gc & 15) * 8); } } while (0)
#define RT_BWRITE(buf) do { _Pragma("unroll") for (int q = 0; q < 3; ++q) { const int gc = tid + 512 * q, rw = gc >> 4, ch = gc & 15; \
            if (gc < 1280) *(LAS u32x4*)(Bb + (buf) * 20480 + rw * 256 + ((ch ^ (rw & 15)) << 4)) = bst[q]; } } while (0)
#define RT_XLOAD(X, cc) do { const bf16_t* xp_ = xrow + (size_t)RT_KC(cc) * 128; X[0] = *(const u32x4*)(xp_); X[1] = *(const u32x4*)(xp_ + 32); } while (0)
#define RT_STEP(cc, X) do { const LAS unsigned char* bp_ = Bb + ((cc) & 1) * 20480 + r * 256; \
            bf16x8 bfr_[2][5]; \
            _Pragma("unroll") for (int u = 0; u < 2; ++u) { const int sl_ = ((((half * 2 + u) * 4 + g4) ^ r) << 4); \
                _Pragma("unroll") for (int nt = 0; nt < 5; ++nt) bfr_[u][nt] = *(const LAS bf16x8*)(bp_ + nt * 4096 + sl_); } \
            _Pragma("unroll") for (int u = 0; u < 2; ++u) { \
                const float a0 = bf_lo(X[u].x), a1 = bf_hi(X[u].x), a2 = bf_lo(X[u].y), a3 = bf_hi(X[u].y), a4 = bf_lo(X[u].z), a5 = bf_hi(X[u].z), a6 = bf_lo(X[u].w), a7 = bf_hi(X[u].w); \
                ss += ((a0 * a0 + a1 * a1) + (a2 * a2 + a3 * a3)) + ((a4 * a4 + a5 * a5) + (a6 * a6 + a7 * a7)); } \
            __builtin_amdgcn_sched_barrier(0); \
            _Pragma("unroll") for (int u = 0; u < 2; ++u) { const bf16x8 af = __builtin_bit_cast(bf16x8, X[u]); \
                _Pragma("unroll") for (int nt = 0; nt < 5; ++nt) acc[nt] = mfma16(af, bfr_[u][nt], acc[nt]); } \
            __builtin_amdgcn_sched_barrier(0); \
            if ((cc) + 4 < 32) RT_XLOAD(X, (cc) + 4); \
            if ((cc) + 1 < 32) { RT_BWRITE(((cc) + 1) & 1); if ((cc) + 2 < 32) RT_BLOAD((cc) + 2); } \
            LDS_BARRIER(); } while (0)
        __syncthreads();
        RT_BLOAD(0); RT_XLOAD(x0, 0); RT_XLOAD(x1, 1); RT_XLOAD(x2, 2); RT_XLOAD(x3, 3);
        RT_BWRITE(0); RT_BLOAD(1);
        LDS_BARRIER();
#pragma unroll 1
        for (int c0 = 0; c0 < 32; c0 += 4) { RT_STEP(c0, x0); RT_STEP(c0 + 1, x1); RT_STEP(c0 + 2, x2); RT_STEP(c0 + 3, x3); }
#undef RT_KC
#undef RT_BLOAD
#undef RT_BWRITE
#undef RT_XLOAD
#undef RT_STEP
        ss += __shfl_xor(ss, 16); ss += __shfl_xor(ss, 32);
#pragma unroll
        for (int nt = 0; nt < 5; ++nt)
#pragma unroll
            for (int rr = 0; rr < 4; ++rr) lg[(4 * g4 + rr) * 81 + 16 * nt + r] = acc[nt][rr];
        if (lane < 16) lg[16 * 81 + lane] = ss;
        __syncthreads();
        if (half == 0 && lane < 16) {
            const int token = row0 + lane; const LAS float* lr = lg + lane * 81; const LAS float* lr2 = lr + (16 * 81 + 16);
            const float rstd = 1.0f / sqrtf((lg[16 * 81 + lane] + lg[(16 * 81 + 16) + 16 * 81 + lane]) * (1.0f / DM) + EPS);
            float best = -3.0e38f; int gsel = 0; float glv[8];
#pragma unroll
            for (int j = 0; j < 8; ++j) { glv[j] = (lr[j] + lr2[j]) * rstd + F.rgb[j]; if (glv[j] > best) { best = glv[j]; gsel = j; } }
            float sum = 0.f;
#pragma unroll
            for (int j = 0; j < 8; ++j) sum += expf(glv[j] - best);
            const float gp = 1.0f / sum;
            float b1 = -3.0e38f, b2 = -3.0e38f; int i1 = 0, i2 = 0;
#pragma unroll
            for (int j = 0; j < 8; ++j) { const float v = (lr[8 + gsel * 8 + j] + lr2[8 + gsel * 8 + j]) * rstd + F.reb[gsel * 8 + j];
                if (v > b1) { b2 = b1; i2 = i1; b1 = v; i1 = j; } else if (v > b2) { b2 = v; i2 = j; } }
            const float e2 = expf(b2 - b1); const float w1 = gp / (1.0f + e2), w2 = gp * e2 / (1.0f + e2);
            F.RSTD2[token] = rstd;
            const int ex1 = gsel * 8 + i1, ex2 = gsel * 8 + i2;
            const unsigned p1 = atomicAdd(F.ctl + CW_CNT + 64 * ex1, 1u); F.LIST[ex1 * LISTCAP + p1] = token * 2; F.AW[token * 2] = w1; F.APOS[token * 2] = (ex1 << 16) | (int)p1;
            const unsigned p2 = atomicAdd(F.ctl + CW_CNT + 64 * ex2, 1u); F.LIST[ex2 * LISTCAP + p2] = token * 2 + 1; F.AW[token * 2 + 1] = w2; F.APOS[token * 2 + 1] = (ex2 << 16) | (int)p2;
        }
        __syncthreads();
    }
}

__device__ __forceinline__ void phase_final(Frame& F) {
    const int gw = F.vcu * 8 + F.wave, NGW = F.G * 8;
    const LAS int* tstart = (const LAS int*)(F.lds + TAB_OFF) + 64;
    u32x2 xa[16], pa[16], qa[16], xb[16], pb[16], qb[16]; float w0a, w1a, w0b, w1b;
#define FIN_LOAD(m, X, P, Q, W0, W1) do { const int ap0_ = F.APOS[2 * (m)], ap1_ = F.APOS[2 * (m) + 1]; W0 = F.AW[2 * (m)]; W1 = F.AW[2 * (m) + 1]; \
        const int row0_ = tstart[ap0_ >> 16] * 256 + (ap0_ & 0xffff), row1_ = tstart[ap1_ >> 16] * 256 + (ap1_ & 0xffff); \
        const u32x2* xr_ = (const u32x2*)(F.X1 + (size_t)(m) * DM) + F.lane; const u32x2* y0_ = (const u32x2*)(F.YT + (size_t)row0_ * DM) + F.lane; const u32x2* y1_ = (const u32x2*)(F.YT + (size_t)row1_ * DM) + F.lane; \
        _Pragma("unroll") for (int j = 0; j < 16; ++j) { X[j] = __builtin_nontemporal_load(xr_ + 64 * j); P[j] = __builtin_nontemporal_load(y0_ + 64 * j); Q[j] = __builtin_nontemporal_load(y1_ + 64 * j); } } while (0)
    int m = gw;
    if (m < NTOK) FIN_LOAD(m, xa, pa, qa, w0a, w1a);
    for (; m < NTOK; m += NGW) {
        const bool has = (m + NGW) < NTOK;
        if (has) FIN_LOAD(m + NGW, xb, pb, qb, w0b, w1b);
        f32x4* orow = (f32x4*)(F.out + (size_t)m * DM) + F.lane; const f32x4* gr = (const f32x4*)F.gf + F.lane;
        f32x4 v[16]; float ss = 0.f;
#pragma unroll
        for (int j = 0; j < 16; ++j) { const f32x4 a = (f32x4){bf_lo(xa[j].x), bf_hi(xa[j].x), bf_lo(xa[j].y), bf_hi(xa[j].y)};
            v[j].x = a.x + w0a * bf_lo(pa[j].x) + w1a * bf_lo(qa[j].x); v[j].y = a.y + w0a * bf_hi(pa[j].x) + w1a * bf_hi(qa[j].x); v[j].z = a.z + w0a * bf_lo(pa[j].y) + w1a * bf_lo(qa[j].y); v[j].w = a.w + w0a * bf_hi(pa[j].y) + w1a * bf_hi(qa[j].y);
            ss += (v[j].x * v[j].x + v[j].y * v[j].y) + (v[j].z * v[j].z + v[j].w * v[j].w); }
        ss = wave_sum(ss);
        const float rstd = 1.0f / sqrtf(ss * (1.0f / DM) + EPS);
#pragma unroll
        for (int j = 0; j < 16; ++j) __builtin_nontemporal_store(v[j] * rstd * gr[64 * j], orow + 64 * j);
        if (has) { w0a = w0b; w1a = w1b;
#pragma unroll
            for (int j = 0; j < 16; ++j) { xa[j] = xb[j]; pa[j] = pb[j]; qa[j] = qb[j]; } }
    }
#undef FIN_LOAD
}

__device__ __forceinline__ int moe_tables(Frame& F) {
    LAS int* cnts = (LAS int*)(F.lds + TAB_OFF); LAS int* tstart = cnts + 64; LAS int* tl = cnts + 144;
    __syncthreads();
    if (F.tid < 64) {
        const int e = F.tid, cnt = (int)F.ctl[CW_CNT + 64 * e]; cnts[e] = cnt;
        const int nt = (cnt + 255) >> 8, nsmall = (nt > 0 && cnt - 256 * (nt - 1) <= 128) ? 1 : 0, nbig = nt - nsmall;
        int pt = nt, pb = nbig, ps = nsmall;
#pragma unroll
        for (int o = 1; o < 64; o <<= 1) { const int a = __shfl_up(pt, o), b = __shfl_up(pb, o), c = __shfl_up(ps, o); if (e >= o) { pt += a; pb += b; ps += c; } }
        const int Tb = __shfl(pb, 63), T = __shfl(pt, 63);
        tstart[e] = pt - nt; if (e == 63) { tstart[64] = T; cnts[130] = Tb; }
        for (int t = 0; t < nbig; ++t) tl[pb - nbig + t] = (e << 8) | t;
        if (nsmall) tl[Tb + ps - 1] = (e << 8) | (nt - 1);
    }
    __syncthreads();
    return tstart[64];
}
__device__ __forceinline__ const float* in_ptr(LAS unsigned char* lds, int k) {
    const unsigned long long v = ((const LAS unsigned long long*)(lds + PTAB_OFF))[k];
    const unsigned lo = __builtin_amdgcn_readfirstlane((unsigned)v), hi = __builtin_amdgcn_readfirstlane((unsigned)(v >> 32));
    return (const float*)(const GAS float*)(((unsigned long long)hi << 32) | lo);
}
constexpr int N_PHASES = 10;
struct Args { const float* in[19]; float* out; unsigned char* ws; int ph_lo, ph_hi, li, pad; };
__global__ void __launch_bounds__(512, 2) fwd_kernel(Args args) {
    extern __shared__ __attribute__((aligned(16))) unsigned char lds_raw[];
    Frame F;
    F.lds = (LAS unsigned char*)lds_raw;
    volatile LAS unsigned* MISC = (volatile LAS unsigned*)(F.lds + MISC_OFF);
    F.tid = threadIdx.x; F.lane = F.tid & 63; F.wave = __builtin_amdgcn_readfirstlane(F.tid >> 6);
    F.G = gridDim.x; { const int bx = blockIdx.x; F.vcu = (F.G % 8 == 0) ? (bx % 8) * (F.G / 8) + bx / 8 : bx; }
    unsigned char* ws = args.ws;
    F.ctl = (unsigned*)(ws + WS_CTL);
    F.out = args.out;
    for (int u = F.tid; u < 128; u += 512) ((LAS unsigned*)(F.lds + MISC_OFF))[u] = 0u;
    __syncthreads();
    if (F.tid == 0) { LAS unsigned long long* pt = (LAS unsigned long long*)(F.lds + PTAB_OFF);
#pragma unroll
        for (int k = 0; k < 19; ++k) pt[k] = (unsigned long long)args.in[k]; }
    __syncthreads();
#define INP(k) in_ptr(F.lds, (k))
#define WSP(T, off) ((T*)(ws + (off)))
    XcdBarrier bar; bar.bar = F.ctl + CW_BAR; bar.x = 0; bar.st = nullptr;
    if (MK_N_LAUNCHES == 1) bar = xcd_barrier_post(F.ctl + CW_BAR, MISC + 8);
    const int lo = args.ph_lo, hi = args.ph_hi;
#ifndef PHASE_MASK
#define PHASE_MASK 0x3ff
#endif
#define IN(k) ((((PHASE_MASK) >> (k)) & 1) && lo <= (k) && (k) < hi)
#define RELANE() do { int l_ = (int)__builtin_amdgcn_mbcnt_hi(~0u, __builtin_amdgcn_mbcnt_lo(~0u, 0u)); asm volatile("" : "+v"(l_)); F.lane = l_; F.tid = F.wave * 64 + F.lane; } while (0)
#define SEAM(k) do { if (IN(k) && IN((k) + 1)) xcd_barrier(bar, F.wave == 0 && __builtin_amdgcn_mbcnt_hi(~0u, __builtin_amdgcn_mbcnt_lo(~0u, 0u)) == 0u); } while (0)
#ifndef REPS_MASK
#define REPS_MASK 0
#endif
#define NREP(k) ((((REPS_MASK) >> (k)) & 1) ? 2 : 1)

    if (IN(0)) { RELANE(); F.g2 = INP(10); F.x = INP(0); F.g1 = INP(1); F.w_in = INP(2); F.w_out = INP(9); F.rgw = INP(11); F.rew = INP(13); F.wg = INP(15); F.wu = INP(16); F.wd = INP(17);
        F.ACT = WSP(bf16_t, WS_ACT); F.GATES = WSP(float, WS_GATES); F.WIN_T = WSP(bf16_t, WS_WIN); F.WOUT_T = WSP(bf16_t, WS_WOUT); F.WGU_T = WSP(bf16_t, WS_WGU); F.WD_T = WSP(bf16_t, WS_WD); F.WRT = WSP(bf16_t, WS_WRT);
        for (int rep = 0; rep < NREP(0); ++rep) { phase0(F); RELANE(); phase0b(F); __syncthreads(); } } SEAM(0);
    if (IN(1)) { RELANE();
        if ((int)blockIdx.x < 16) { F.igb = INP(6); F.fgb = INP(7); F.GATES = WSP(float, WS_GATES); F.GS = WSP(float, WS_GS); for (int bh = (int)blockIdx.x; bh < 16; bh += F.G) phase_gates(F, bh); RELANE(); }
        if ((int)blockIdx.x < NCONV && F.G > 2 * NCONV) {
            F.g2 = INP(10); F.wg = INP(15); F.wu = INP(16); F.wd = INP(17); F.WGU_T = WSP(bf16_t, WS_WGU); F.WD_T = WSP(bf16_t, WS_WD); F.w_in = INP(2); F.w_out = INP(9); F.WIN_T = WSP(bf16_t, WS_WIN); F.WOUT_T = WSP(bf16_t, WS_WOUT);
            phase_convert(F, ITEMS_DENSE, NITEMS, (int)blockIdx.x * 8 + F.wave, -(NCONV * 8)); __syncthreads();
        } else if (F.G <= 2 * NCONV) {
            F.g2 = INP(10); F.wg = INP(15); F.wu = INP(16); F.wd = INP(17); F.WGU_T = WSP(bf16_t, WS_WGU); F.WD_T = WSP(bf16_t, WS_WD); F.w_in = INP(2); F.w_out = INP(9); F.WIN_T = WSP(bf16_t, WS_WIN); F.WOUT_T = WSP(bf16_t, WS_WOUT);
            phase_convert(F, ITEMS_DENSE, NITEMS, F.vcu * 8 + F.wave, F.G * 8); __syncthreads(); }
        { pg8::DynSched<4096> S; S.init(NTOK, NPROJ, WSP(bf16_t, WS_ACT), WSP(bf16_t, WS_WIN), F.ctl + CW_Q1, (volatile LAS int*)(F.lds + TAB_OFF), (int)xb_xcc_id()); S.t0 = (F.tid == 0); S.prime();
          pg8::EpiProj E{WSP(bf16_t, WS_PROJ), WSP(bf16_t, WS_QH), WSP(bf16_t, WS_KH), WSP(bf16_t, WS_VH), WSP(float, WS_VSSP)};
          pg8::gemm_phase<pg8::EpiProj, pg8::DynSched<4096>, 4096>(F.lds, S, E, F.wave, F.lane); }
        } SEAM(1);
    if (IN(2)) { RELANE(); F.gvn = INP(3); F.gsw = INP(4); F.gsb = INP(5); F.igb = INP(6); F.fgb = INP(7);
        F.PROJ = WSP(bf16_t, WS_PROJ); F.ACT = WSP(bf16_t, WS_ACT); F.GATES = WSP(float, WS_GATES); F.HB = WSP(float, WS_HB); F.QH = WSP(bf16_t, WS_QH); F.KH = WSP(bf16_t, WS_KH); F.VH = WSP(bf16_t, WS_VH); F.VSSP = WSP(float, WS_VSSP); F.GS = WSP(float, WS_GS);
#ifndef P2_SEL
#define P2_SEL 3
#endif
        F.PM = WSP(bf16_t, WS_PM); F.KP = WSP(bf16_t, WS_KP); phase_mlstm_pre(F);
        if (MK_N_LAUNCHES == 1) xcd_barrier(bar, F.wave == 0 && __builtin_amdgcn_mbcnt_hi(~0u, __builtin_amdgcn_mbcnt_lo(~0u, 0u)) == 0u);
        RELANE();
        for (int rep = 0; rep < NREP(9); ++rep) phase_mlstm(F); RELANE(); for (int rep = 0; rep < NREP(10); ++rep) phase_gmlp(F); } SEAM(2);
    if (IN(3)) { RELANE(); F.ogn = INP(8); F.PROJ = WSP(bf16_t, WS_PROJ); F.ACT = WSP(bf16_t, WS_ACT); F.HB = WSP(float, WS_HB); for (int rep = 0; rep < NREP(3); ++rep) phase_mlnorm(F); } SEAM(3);
    if (IN(4)) { RELANE(); pg8::DenseSched<4096> S; S.init(NTOK, DM, F.G, (int)blockIdx.x, WSP(bf16_t, WS_ACT), WSP(bf16_t, WS_WOUT)); pg8::EpiRes E{INP(0), WSP(bf16_t, WS_X1)};
        pg8::gemm_phase<pg8::EpiRes, pg8::DenseSched<4096>, 4096>(F.lds, S, E, F.wave, F.lane);
        if (NREP(4) == 2) { __syncthreads(); pg8::gemm_phase<pg8::EpiRes, pg8::DenseSched<4096>, 4096>(F.lds, S, E, F.wave, F.lane); } } SEAM(4);
    if (IN(5)) { RELANE(); F.g2 = INP(10); F.rgb = INP(12); F.reb = INP(14); F.ACT = WSP(bf16_t, WS_ACT); F.WRT = WSP(bf16_t, WS_WRT); F.RSTD2 = WSP(float, WS_RSTD2); F.AW = WSP(float, WS_AW); F.LIST = WSP(int, WS_LIST); F.APOS = WSP(int, WS_APOS); F.X1 = WSP(bf16_t, WS_X1);
        phase_router(F); } SEAM(5);
#define MOE_SCHED_INIT(S) do { S.cnts = (const LAS int*)(F.lds + TAB_OFF); S.tstart = S.cnts + 64; S.tl = S.cnts + 144; S.G = F.G; S.c = F.vcu; S.list = WSP(int, WS_LIST); S.ctr = nullptr; S.slot = nullptr; S.t0 = false; } while (0)
#define MOE_GU(S) do { S.A = (const char*)WSP(bf16_t, WS_X1); S.Bt = (const char*)WSP(bf16_t, WS_WGU); S.bexp = (size_t)1024 * DM * 2; } while (0)
#define MOE_DN(S) do { S.A = (const char*)WSP(bf16_t, WS_HM); S.Bt = (const char*)WSP(bf16_t, WS_WD); S.bexp = (size_t)DM * DEXP * 2; } while (0)
    if (IN(6)) { RELANE(); const int T = moe_tables(F); const int U6 = (T * 4 < ((2 * F.G) & ~3)) ? T * 4 : ((2 * F.G) & ~3);
        pg8::MoeSched<4096, 2, true> S; MOE_SCHED_INIT(S); MOE_GU(S); S.u_lo = 0; S.u_hi = U6;
        pg8::EpiGU E{WSP(bf16_t, WS_HM), WSP(int, WS_LIST), WSP(float, WS_RSTD2)};
        pg8::gemm_phase<pg8::EpiGU, pg8::MoeSched<4096, 2, true>, 4096, true>(F.lds, S, E, F.wave, F.lane); } SEAM(6);
    if (IN(7)) { RELANE(); const int T = ((const LAS int*)(F.lds + TAB_OFF))[128];     const int U6 = (T * 4 < ((2 * F.G) & ~3)) ? T * 4 : ((2 * F.G) & ~3); const int T6 = U6 >> 2;
        { pg8::MoeSched<4096, 2, true, true> S; MOE_SCHED_INIT(S); MOE_GU(S); S.u_lo = U6; S.u_hi = T * 4; S.ctr = F.ctl + CW_QA; S.slot = (volatile LAS int*)(F.lds + TAB_OFF + 1408); S.t0 = (F.tid == 0); S.prime();
          pg8::EpiGU E{WSP(bf16_t, WS_HM), WSP(int, WS_LIST), WSP(float, WS_RSTD2)};
          pg8::gemm_phase<pg8::EpiGU, pg8::MoeSched<4096, 2, true, true>, 4096, true>(F.lds, S, E, F.wave, F.lane); }
        __syncthreads(); RELANE();
        { pg8::MoeSched<512, 4, false, true> S; MOE_SCHED_INIT(S); MOE_DN(S); S.u_lo = 0; S.u_hi = T6 * 16; S.ctr = F.ctl + CW_QB; S.slot = (volatile LAS int*)(F.lds + TAB_OFF + 1440); S.t0 = (F.tid == 0); S.prime();
          pg8::EpiDown E{WSP(bf16_t, WS_YT)};
          pg8::gemm_phase<pg8::EpiDown, pg8::MoeSched<512, 4, false, true>, 512, true>(F.lds, S, E, F.wave, F.lane); } } SEAM(7);
    if (IN(8)) { RELANE(); const int T = ((const LAS int*)(F.lds + TAB_OFF))[128]; const int U6 = (T * 4 < ((2 * F.G) & ~3)) ? T * 4 : ((2 * F.G) & ~3); const int T6 = U6 >> 2;
        pg8::MoeSched<512, 4, false> S; MOE_SCHED_INIT(S); MOE_DN(S); S.u_lo = T6 * 16; S.u_hi = T * 16;
        pg8::EpiDown E{WSP(bf16_t, WS_YT)};
        pg8::gemm_phase<pg8::EpiDown, pg8::MoeSched<512, 4, false>, 512, true>(F.lds, S, E, F.wave, F.lane); } SEAM(8);
    if (IN(9)) { RELANE(); F.gf = INP(18); F.YT = WSP(bf16_t, WS_YT); F.AW = WSP(float, WS_AW); F.APOS = WSP(int, WS_APOS); F.X1 = WSP(bf16_t, WS_X1);
        phase_final(F); }
#undef IN
#undef SEAM
}

extern "C" void kernel_launch(void* const* d_in, const int* in_sizes, int n_in, void* d_out, int out_size, void* d_ws, size_t ws_size, hipStream_t stream) {
    static int grid = 0;
    if (grid == 0) {
        if (n_in != 19 || out_size != NTOK * DM || ws_size < WS_END) { fprintf(stderr, "kernel_launch: unexpected shapes (n_in %d, out %d, ws %zu)\n", n_in, out_size, ws_size); grid = -1; return; }
        int dev = 0, cus = 0, per_cu = 0;
        if (hipGetDevice(&dev) != hipSuccess || hipDeviceGetAttribute(&cus, hipDeviceAttributeMultiprocessorCount, dev) != hipSuccess) { grid = -1; return; }
        if (hipFuncSetAttribute((const void*)fwd_kernel, hipFuncAttributeMaxDynamicSharedMemorySize, LDS_BYTES) != hipSuccess) { fprintf(stderr, "kernel_launch: hipFuncSetAttribute failed\n"); grid = -1; return; }
        if (hipOccupancyMaxActiveBlocksPerMultiprocessor(&per_cu, (const void*)fwd_kernel, 512, LDS_BYTES) != hipSuccess || per_cu < 1) fprintf(stderr, "kernel_launch: occupancy query reports %d\n", per_cu);
        (void)hipGetLastError();
        grid = cus;
    }
    if (grid < 0) return;
    if (hipMemsetAsync((char*)d_ws + WS_CTL, 0, CTL_ZERO_BYTES, stream) != hipSuccess) return;
    Args a{};
    for (int i = 0; i < 19; ++i) a.in[i] = (const float*)d_in[i];
    a.out = (float*)d_out; a.ws = (unsigned char*)d_ws; a.pad = 0;
    if (MK_N_LAUNCHES == 1) { a.ph_lo = 0; a.ph_hi = N_PHASES; a.li = 0; hipLaunchKernelGGL(fwd_kernel, dim3(grid), dim3(512), LDS_BYTES, stream, a); }
    else for (int li = 0; li < N_PHASES; ++li) { a.ph_lo = li; a.ph_hi = li + 1; a.li = li; hipLaunchKernelGGL(fwd_kernel, dim3(grid), dim3(512), LDS_BYTES, stream, a); }
}
```

```cpp
#include <hip/hip_runtime.h>
#include <cstdio>
#include <cstdint>

#ifndef MK_N_LAUNCHES
#define MK_N_LAUNCHES 1
#endif

#define LAS __attribute__((address_space(3)))
#define GAS __attribute__((address_space(1)))
typedef unsigned short bf16_t;
typedef short bf16x8 __attribute__((ext_vector_type(8)));
typedef float f32x4 __attribute__((ext_vector_type(4)));
typedef float f32x2 __attribute__((ext_vector_type(2)));
typedef unsigned u32x4 __attribute__((ext_vector_type(4)));
typedef unsigned u32x2 __attribute__((ext_vector_type(2)));

constexpr int DM = 4096, NTOK = 16384, SEQL = 4096;
constexpr int NPROJ = 10240, LDW_IN = 10248;
constexpr int C_U = 0, C_V = 2048, C_Q = 4096, C_K = 5120, C_VB = 6144, C_O = 8192;
constexpr int NEXP = 64, DEXP = 512, LISTCAP = 16384;
constexpr float EPS = 1e-6f;

constexpr size_t MiB = 1u << 20;
constexpr size_t WS_CTL = 0, CTL_ZERO_BYTES = 1 * MiB;
constexpr size_t WS_GATES = 1 * MiB;
constexpr size_t WS_RSTD2 = 1 * MiB + 512 * 1024;
constexpr size_t WS_AW = WS_RSTD2 + 64 * 1024;
constexpr size_t WS_APOS = WS_AW + 128 * 1024;
constexpr size_t WS_WRT = 2 * MiB;
constexpr size_t WS_LIST = 3 * MiB;
constexpr size_t WS_GT = 7 * MiB + 768 * 1024;
constexpr size_t WS_GS = 7 * MiB;
constexpr size_t WS_WIN = 8 * MiB;
constexpr size_t WS_WOUT = 88 * MiB;
constexpr size_t WS_WGU = 120 * MiB;
constexpr size_t WS_WD = 632 * MiB;
constexpr size_t WS_ACT = 888 * MiB;
constexpr size_t WS_PROJ = 1016 * MiB;
constexpr size_t WS_YT = WS_PROJ;
constexpr size_t WS_HM = 1464 * MiB;
constexpr size_t WS_PM = WS_HM;
constexpr size_t WS_KP = WS_HM + 16 * MiB;
constexpr size_t WS_HB = 1336 * MiB;
constexpr size_t WS_QH = 1512 * MiB;
constexpr size_t WS_KH = 1544 * MiB;
constexpr size_t WS_VH = 1576 * MiB;
constexpr size_t WS_X1 = 1640 * MiB;
constexpr size_t WS_VSSP = 1768 * MiB;
constexpr size_t WS_END = 1770 * MiB;
constexpr int CW_BAR = 4096;
constexpr int CW_CNT = 16384;
constexpr int CW_QA = 26624, CW_QB = 26688;
constexpr int CW_Q1 = 24576;

constexpr int LDS_BYTES = 147456;
constexpr int TAB_OFF = 131072;
constexpr int MISC_OFF = LDS_BYTES - 512;
constexpr int PTAB_OFF = MISC_OFF + 256;

__device__ __forceinline__ unsigned f2bf(float f) { unsigned u = __builtin_bit_cast(unsigned, f); return (u + 0x7fffu + ((u >> 16) & 1u)) >> 16; }
__device__ __forceinline__ float bf2f(unsigned b) { return __builtin_bit_cast(float, b << 16); }
__device__ __forceinline__ unsigned pk2(float lo, float hi) { return f2bf(lo) | (f2bf(hi) << 16); }
__device__ __forceinline__ float bf_lo(unsigned w) { return __builtin_bit_cast(float, w << 16); }
__device__ __forceinline__ float bf_hi(unsigned w) { return __builtin_bit_cast(float, w & 0xffff0000u); }
__device__ __forceinline__ float wave_sum(float v) {
#pragma unroll
    for (int o = 1; o < 64; o <<= 1) v += __shfl_xor(v, o);
    return v;
}
__device__ __forceinline__ float fast_exp(float x) { return __builtin_amdgcn_exp2f(x * 1.4426950408889634f); }
__device__ __forceinline__ float gelu_tanh(float x) {
    const float t = x * (1.0f + 0.044715f * x * x) * 1.5957691216057308f;
    return x * __builtin_amdgcn_rcpf(1.0f + fast_exp(-t));
}
__device__ __forceinline__ float sigmoid_f(float x) { return __builtin_amdgcn_rcpf(1.0f + fast_exp(-x)); }
__device__ __forceinline__ unsigned cvtpk(float lo, float hi) { unsigned r; asm volatile("v_cvt_pk_bf16_f32 %0, %1, %2" : "=v"(r) : "v"(lo), "v"(hi)); return r; }
#define LDS_WAIT() asm volatile("s_waitcnt lgkmcnt(0)" ::: "memory")
#define VM_WAIT() asm volatile("s_waitcnt vmcnt(0)" ::: "memory")
#define LDS_BARRIER() do { asm volatile("s_waitcnt lgkmcnt(0)" ::: "memory"); __builtin_amdgcn_s_barrier(); asm volatile("" ::: "memory"); } while (0)
__device__ __forceinline__ f32x4 mfma16(bf16x8 a, bf16x8 b, f32x4 c) { return __builtin_amdgcn_mfma_f32_16x16x32_bf16(a, b, c, 0, 0, 0); }

namespace pg8 {
constexpr int BM = 256, BK = 64, HALF = 128, HTB = HALF * BK * 2, STAGE_BYTES = 8 * HTB, NXCD = 8, WGM = 8;
__host__ __device__ __forceinline__ int lds_byte(int r, int c) { const int st = (r >> 4) * 2 + (c >> 5), rr = r & 15, cc = c & 31, ob = rr * 64 + cc * 2; return st * 1024 + (ob ^ (((ob >> 9) & 1) << 5)); }
__host__ __device__ __forceinline__ void stage_rc(int b, int& R, int& C) { const int st = b / 1024, sb = b % 1024, swz = sb ^ (((sb >> 9) & 1) << 5); R = (st >> 1) * 16 + swz / 64; C = (st & 1) * 32 + (swz % 64) / 2; }
__host__ __device__ __forceinline__ int perm32(int rho) { const int n = rho >> 4, i = rho & 15; return 8 * (i >> 2) + 4 * n + (i & 3); }

struct Unit { int pm, pn, e, nvalid, rowbase; };

template <int K> struct DenseSched {
    int nM, nN, nwg, G, c; const char* A; const char* Bt;
    __device__ void init(int M, int N, int G_, int c_, const void* A_, const void* Bt_) { nM = M / BM; nN = N / BM; nwg = nM * nN; G = G_; c = c_; A = (const char*)A_; Bt = (const char*)Bt_; }
    __device__ __forceinline__ bool next(int i, Unit& u) const {
        const long L = (long)i * G + c; if (L >= nwg) return false;
        int wgid = (int)L; { const int q = nwg / NXCD, r = nwg % NXCD, xcd = wgid % NXCD, off = wgid / NXCD; wgid = (xcd < r ? xcd * (q + 1) : r * (q + 1) + (xcd - r) * q) + off; }
        const int nig = WGM * nN, gid = wgid / nig, fm = gid * WGM, gsz = (nM - fm) < WGM ? (nM - fm) : WGM;
        u.pm = fm + ((wgid % nig) % gsz); u.pn = (wgid % nig) / gsz; u.e = 0; u.nvalid = 256; u.rowbase = u.pm * 256; return true;
    }
    __device__ __forceinline__ const char* a_base() const { return A; }
    __device__ __forceinline__ unsigned a_off(const Unit& u, int row) const { return (unsigned)(u.pm * 256 + row) * (unsigned)(K * 2); }
    __device__ __forceinline__ const char* b_ptr(const Unit& u) const { return Bt + (size_t)u.pn * 256 * K * 2; }
};
template <int K> struct DynSched {
    int nM, nN, nwg, xcc; const char* A; const char* Bt; unsigned* ctr; volatile LAS int* slot; bool t0;
    __device__ void init(int M, int N, const void* A_, const void* Bt_, unsigned* ctr_, volatile LAS int* slot_, int xcc_) { nM = M / BM; nN = N / BM; nwg = nM * nN; A = (const char*)A_; Bt = (const char*)Bt_; ctr = ctr_; slot = slot_; xcc = xcc_ & 7; }
    __device__ __forceinline__ int draw() const {
        const int per = nwg / NXCD;
        for (int a = 0; a < NXCD; ++a) { const int x = (xcc + a) & 7; const int n = (int)__hip_atomic_fetch_add(ctr + 64 * x, 1u, __ATOMIC_RELAXED, __HIP_MEMORY_SCOPE_AGENT); if (n < per) return NXCD * n + x; }
        return nwg;
    }
    __device__ __forceinline__ void prime() const {
        if (t0) { slot[0] = draw(); slot[1] = draw(); }
        __syncthreads();
    }
    __device__ __forceinline__ bool next(int i, Unit& u) const {
        const int L = __builtin_amdgcn_readfirstlane(slot[i & 3]);
        if (i >= 1 && t0) slot[(i + 1) & 3] = (L < nwg) ? draw() : nwg;
        if (L >= nwg) return false;
        int wgid = L; { const int q = nwg / NXCD, r = nwg % NXCD, xcd = wgid % NXCD, off = wgid / NXCD; wgid = (xcd < r ? xcd * (q + 1) : r * (q + 1) + (xcd - r) * q) + off; }
        const int nig = WGM * nN, gid = wgid / nig, fm = gid * WGM, gsz = (nM - fm) < WGM ? (nM - fm) : WGM;
        u.pm = fm + ((wgid % nig) % gsz); u.pn = (wgid % nig) / gsz; u.e = 0; u.nvalid = 256; u.rowbase = u.pm * 256; return true;
    }
    __device__ __forceinline__ const char* a_base() const { return A; }
    __device__ __forceinline__ unsigned a_off(const Unit& u, int row) const { return (unsigned)(u.pm * 256 + row) * (unsigned)(K * 2); }
    __device__ __forceinline__ const char* b_ptr(const Unit& u) const { return Bt + (size_t)u.pn * 256 * K * 2; }
};
template <int K, int NPN_SHIFT, bool GATHER, bool DYN = false> struct MoeSched {
    const LAS int* cnts; const LAS int* tstart; const LAS int* tl; int u_lo, u_hi, G, c; const int* list; const char* A; const char* Bt; size_t bexp;
    unsigned* ctr; volatile LAS int* slot; bool t0;
    __device__ __forceinline__ int draw() const { return (int)__hip_atomic_fetch_add(ctr, 1u, __ATOMIC_RELAXED, __HIP_MEMORY_SCOPE_AGENT); }
    __device__ __forceinline__ void prime() const { if (t0) { slot[0] = draw(); slot[1] = draw(); } __syncthreads(); }
    __device__ __forceinline__ bool next(int i, Unit& u) const {
        int L;
        if (DYN) { const int n = __builtin_amdgcn_readfirstlane(slot[i & 3]); const int cntu = u_hi - u_lo;
            if (i >= 1 && t0) slot[(i + 1) & 3] = (n < cntu) ? draw() : cntu;
            if (n >= cntu) return false; L = u_lo + n; }
        else { L = u_lo + i * G + c; if (L >= u_hi) return false; }
        const int pk = __builtin_amdgcn_readfirstlane(tl[L >> NPN_SHIFT]); const int e = pk >> 8;
        u.pn = L & ((1 << NPN_SHIFT) - 1); u.e = e; u.pm = pk & 255;
        int nv = cnts[e] - u.pm * 256; nv = nv > 256 ? 256 : nv; u.nvalid = __builtin_amdgcn_readfirstlane(nv); u.rowbase = __builtin_amdgcn_readfirstlane((tstart[e] + u.pm) * 256); return true;
    }
    __device__ __forceinline__ const char* a_base() const { return A; }
    __device__ __forceinline__ unsigned a_off(const Unit& u, int row) const {
        if (GATHER) { int tok = 0; if (row < u.nvalid) tok = list[u.e * LISTCAP + u.pm * 256 + row] >> 1; return (unsigned)tok * (unsigned)(K * 2); }
        else return (unsigned)(u.rowbase + row) * (unsigned)(K * 2);
    }
    __device__ __forceinline__ const char* b_ptr(const Unit& u) const { return Bt + (size_t)u.e * bexp + (size_t)u.pn * 256 * K * 2; }
};

__device__ __forceinline__ unsigned cvt_pk_bf16(float lo, float hi) { unsigned r; asm volatile("v_cvt_pk_bf16_f32 %0, %1, %2" : "=v"(r) : "v"(lo), "v"(hi)); return r; }

template <class Epi, class Sched, int K, bool SKIP = false>
__device__ __forceinline__ void gemm_phase(LAS unsigned char* lds, const Sched& S, const Epi& E, const int wid, const int lane) {
    const int tid = wid * 64 + lane, wr = wid >> 2, wc = wid & 3, fr = lane & 15, fq = lane >> 4;
    constexpr int nt = K / BK;
    unsigned voffB[2]; int RA[2]; unsigned CA2[2];
#pragma unroll
    for (int i = 0; i < 2; ++i) { int R, C; stage_rc(tid * 16 + i * 8192, R, C); const int Rb = Epi::PERM ? ((R & ~31) + perm32(R & 31)) : R;
        RA[i] = R; CA2[i] = (unsigned)C * 2u; voffB[i] = (unsigned)(Rb * K + C) * 2u; }
    constexpr size_t kstep = (size_t)(BK * 2);
    constexpr size_t hstep = (size_t)HALF * K * 2;
    const unsigned ldsw = (unsigned)wid * 1024u;
    const int aoffl = lds_byte(wr * 64 + fr, fq * 8), boffl = lds_byte(wc * 32 + fr, fq * 8);
#define PG8_SA(b, h) (((b) * 2 + (h)) * HTB)
#define PG8_SB(b, h) ((4 + (b) * 2 + (h)) * HTB)
#define PG8_STAGE(bufoff, gbase, voff) do { _Pragma("unroll") for (int _i = 0; _i < 2; ++_i) \
        __builtin_amdgcn_global_load_lds((const unsigned*)((const char*)(gbase) + (voff)[_i]), (LAS unsigned*)(lds + (bufoff) + ldsw + _i * 8192), 16, 0, 0); } while (0)
#define PG8_LDA(dst, b, h) do { _Pragma("unroll") for (int m = 0; m < 4; ++m) _Pragma("unroll") for (int k = 0; k < 2; ++k) dst[m][k] = *(const LAS bf16x8*)(lds + PG8_SA(b, h) + aoffl + m * 2048 + k * 1024); } while (0)
#define PG8_LDB(dst, b, h) do { _Pragma("unroll") for (int n = 0; n < 2; ++n) _Pragma("unroll") for (int k = 0; k < 2; ++k) dst[n][k] = *(const LAS bf16x8*)(lds + PG8_SB(b, h) + boffl + n * 2048 + k * 1024); } while (0)
#define PG8_MMA(ai, bj, At, Bt) do { if (SKIP && !((ai) ? doA1 : doA0)) break; __builtin_amdgcn_s_setprio(1); _Pragma("unroll") for (int m = 0; m < 4; ++m) _Pragma("unroll") for (int n = 0; n < 2; ++n) _Pragma("unroll") for (int k = 0; k < 2; ++k) \
        acc[ai][bj][m][n] = __builtin_amdgcn_mfma_f32_16x16x32_bf16(Bt[n][k], At[m][k], acc[ai][bj][m][n], 0, 0, 0); __builtin_amdgcn_s_setprio(0); } while (0)
#define PG8_WAIT_V(n) asm volatile("s_waitcnt vmcnt(" #n ")" ::: "memory")
#define PG8_WAIT_L(n) asm volatile("s_waitcnt lgkmcnt(" #n ")" ::: "memory")
#define PG8_BAR __builtin_amdgcn_s_barrier()
#define PG8_SCHED __builtin_amdgcn_sched_barrier(0)
#define PG8_LOAD_AOFF(u) do { _Pragma("unroll") for (int _h = 0; _h < 2; ++_h) _Pragma("unroll") for (int _i = 0; _i < 2; ++_i) aoff[_h][_i] = S.a_off(u, _h * HALF + RA[_i]) + CA2[_i]; } while (0)
    Unit cur, nxt; int ui = 0;
    if (!S.next(0, cur)) return;
    f32x4 acc[2][2][4][2];
#pragma unroll
    for (int a = 0; a < 2; ++a)
#pragma unroll
        for (int b = 0; b < 2; ++b)
#pragma unroll
            for (int m = 0; m < 4; ++m)
#pragma unroll
                for (int n = 0; n < 2; ++n) acc[a][b][m][n] = (f32x4){0.f, 0.f, 0.f, 0.f};
    bf16x8 At[4][2], B0[2][2], B1[2][2];
    unsigned aoff[2][2];
    const char* const Ab = S.a_base();
    const char* cB = S.b_ptr(cur);
    PG8_LOAD_AOFF(cur);
    PG8_STAGE(PG8_SB(0, 0), cB, voffB); PG8_STAGE(PG8_SB(0, 1), cB + hstep, voffB); PG8_STAGE(PG8_SA(0, 0), Ab, aoff[0]); PG8_STAGE(PG8_SA(0, 1), Ab, aoff[1]);
    if (wr == 1) PG8_BAR;
    PG8_WAIT_V(2); PG8_BAR;
    PG8_STAGE(PG8_SB(1, 0), cB + kstep, voffB); PG8_STAGE(PG8_SA(1, 0), Ab + kstep, aoff[0]); PG8_STAGE(PG8_SB(1, 1), cB + hstep + kstep, voffB);
    PG8_WAIT_V(6); PG8_BAR;
    for (;;) {
        const bool has_next = S.next(ui + 1, nxt);
        const bool doA1 = cur.nvalid > 128, doA0 = (wr == 0) || (cur.nvalid > 64);
        const char* nB = has_next ? S.b_ptr(nxt) : cB;
        const char* pA = Ab;
        for (int t = 0; t < nt; t += 2) {
            const bool last = (t == nt - 2);
            const char* b2 = last ? nB : cB + (size_t)(t + 2) * kstep;
            const char* b3 = b2 + kstep;
            PG8_LDB(B0, 0, 0); PG8_LDB(B1, 0, 1); PG8_SCHED; if (!SKIP || doA0) PG8_LDA(At, 0, 0); PG8_STAGE(PG8_SA(1, 1), pA + (size_t)(t + 1) * kstep, aoff[1]);
            if (last) {
                if (has_next) { PG8_LOAD_AOFF(nxt); }
                pA = Ab - (size_t)(t + 2) * kstep;
            }
            PG8_WAIT_V(8); PG8_WAIT_L(0); PG8_BAR; PG8_MMA(0, 0, At, B0); PG8_MMA(0, 1, At, B1); PG8_BAR; PG8_SCHED;
            if (!SKIP || doA1) PG8_LDA(At, 0, 1); PG8_STAGE(PG8_SB(0, 0), b2, voffB); PG8_STAGE(PG8_SB(0, 1), b2 + hstep, voffB); PG8_STAGE(PG8_SA(0, 0), pA + (size_t)(t + 2) * kstep, aoff[0]);
            PG8_WAIT_V(8); PG8_WAIT_L(0); PG8_BAR; PG8_MMA(1, 0, At, B0); PG8_MMA(1, 1, At, B1); PG8_BAR; PG8_SCHED;
            PG8_LDB(B0, 1, 0); PG8_LDB(B1, 1, 1); PG8_SCHED; if (!SKIP || doA0) PG8_LDA(At, 1, 0); PG8_STAGE(PG8_SA(0, 1), pA + (size_t)(t + 2) * kstep, aoff[1]);
            PG8_WAIT_V(8); PG8_WAIT_L(0); PG8_BAR; PG8_MMA(0, 0, At, B0); PG8_MMA(0, 1, At, B1); PG8_BAR; PG8_SCHED;
            if (!SKIP || doA1) PG8_LDA(At, 1, 1); PG8_STAGE(PG8_SB(1, 0), b3, voffB); PG8_STAGE(PG8_SB(1, 1), b3 + hstep, voffB); PG8_STAGE(PG8_SA(1, 0), pA + (size_t)(t + 3) * kstep, aoff[0]);
            PG8_WAIT_V(8); PG8_WAIT_L(0); PG8_BAR; PG8_MMA(1, 0, At, B0); PG8_MMA(1, 1, At, B1); PG8_BAR; PG8_SCHED;
        }
        if (wr == 0) PG8_BAR;
        E(acc, cur, wr, wc, fr, fq);
        if (!has_next) break;
#pragma unroll
        for (int a = 0; a < 2; ++a)
#pragma unroll
            for (int b = 0; b < 2; ++b)
#pragma unroll
                for (int m = 0; m < 4; ++m)
#pragma unroll
                    for (int n = 0; n < 2; ++n) acc[a][b][m][n] = (f32x4){0.f, 0.f, 0.f, 0.f};
        cur = nxt; cB = nB; ++ui;
        if (wr == 1) PG8_BAR;
    }
    PG8_WAIT_V(0);
    PG8_BAR;
#undef PG8_SA
#undef PG8_SB
#undef PG8_STAGE
#undef PG8_LDA
#undef PG8_LDB
#undef PG8_MMA
#undef PG8_WAIT_V
#undef PG8_WAIT_L
#undef PG8_BAR
#undef PG8_SCHED
#undef PG8_LOAD_AOFF
}

struct EpiProj {
    static constexpr bool PERM = true;
    bf16_t* O; bf16_t* QH; bf16_t* KH; bf16_t* VH; float* VSSP;
    __device__ __forceinline__ void operator()(const f32x4 (&acc)[2][2][4][2], const Unit& u, int wr, int wc, int fr, int fq) const {
        const int act = (u.pn < 16) ? 1 : ((u.pn >= 32) ? 2 : 0);
        const float sc = (u.pn >= 20 && u.pn < 24) ? 0.0625f : 1.0f;
        const int row0 = u.pm * BM + wr * 64 + fr;
        bf16_t* base = O + (size_t)u.pn * BM; size_t pitch = NPROJ; size_t hoff = 0;
        if (u.pn >= 16 && u.pn < 24) { const int hh = (u.pn - 16) & 3; base = (u.pn < 20) ? QH : KH; pitch = 256; hoff = (size_t)hh * SEQL * 256; }
        else if (u.pn >= 24 && u.pn < 32) { const int hh = (u.pn - 24) >> 1; base = VH + ((u.pn - 24) & 1) * 256; pitch = 512; hoff = (size_t)hh * SEQL * 512; }
        const int col0 = wc * 32 + 8 * fq; const bool headmajor = (u.pn >= 16 && u.pn < 32);
#pragma unroll
        for (int ai = 0; ai < 2; ++ai)
#pragma unroll
            for (int m = 0; m < 4; ++m) { const int row = row0 + ai * HALF + m * 16;
                bf16_t* rowp = headmajor ? base + (size_t)(row >> 12) * 4 * SEQL * pitch + hoff + (size_t)(row & (SEQL - 1)) * pitch + col0 : base + (size_t)row * pitch + col0;
                float vss = 0.f;
#pragma unroll
                for (int bj = 0; bj < 2; ++bj) { f32x4 v0 = acc[ai][bj][m][0], v1 = acc[ai][bj][m][1];
                    if (act == 1) {
#pragma unroll
                        for (int j = 0; j < 4; ++j) { v0[j] = gelu_tanh(v0[j]); v1[j] = gelu_tanh(v1[j]); vss += v0[j] * v0[j] + v1[j] * v1[j]; } }
                    else if (act == 2) {
#pragma unroll
                        for (int j = 0; j < 4; ++j) { v0[j] = sigmoid_f(v0[j]); v1[j] = sigmoid_f(v1[j]); } }
                    else { v0 = v0 * sc; v1 = v1 * sc; }
                    u32x4 w; w.x = cvt_pk_bf16(v0[0], v0[1]); w.y = cvt_pk_bf16(v0[2], v0[3]); w.z = cvt_pk_bf16(v1[0], v1[1]); w.w = cvt_pk_bf16(v1[2], v1[3]);
                    *(u32x4*)(rowp + bj * HALF) = w; }
                if (u.pn >= 8 && u.pn < 16) { vss += __shfl_xor(vss, 16); vss += __shfl_xor(vss, 32);
                    if (fq == 0) VSSP[(size_t)row * 32 + (u.pn - 8) * 4 + wc] = vss; } }
    }
};
struct EpiRes {
    static constexpr bool PERM = true;
    const float* base; bf16_t* out;
    __device__ __forceinline__ void operator()(const f32x4 (&acc)[2][2][4][2], const Unit& u, int wr, int wc, int fr, int fq) const {
        const int row0 = u.pm * BM + wr * 64 + fr, col0 = u.pn * BM + wc * 32 + 8 * fq;
#pragma unroll
        for (int ai = 0; ai < 2; ++ai)
#pragma unroll
            for (int m = 0; m < 4; ++m) { const size_t off = (size_t)(row0 + ai * HALF + m * 16) * DM + col0;
#pragma unroll
                for (int bj = 0; bj < 2; ++bj) { const f32x4 b0 = *(const f32x4*)(base + off + bj * HALF), b1 = *(const f32x4*)(base + off + bj * HALF + 4);
                    const f32x4 v0 = b0 + acc[ai][bj][m][0], v1 = b1 + acc[ai][bj][m][1];
                    u32x4 w; w.x = cvt_pk_bf16(v0[0], v0[1]); w.y = cvt_pk_bf16(v0[2], v0[3]); w.z = cvt_pk_bf16(v1[0], v1[1]); w.w = cvt_pk_bf16(v1[2], v1[3]);
                    *(u32x4*)(out + off + bj * HALF) = w; } }
    }
};
struct EpiGU {
    static constexpr bool PERM = true;
    bf16_t* HM; const int* list; const float* rstd2;
    __device__ __forceinline__ void operator()(const f32x4 (&acc)[2][2][4][2], const Unit& u, int wr, int wc, int fr, int fq) const {
        const int col0 = u.pn * 128 + wc * 32 + 8 * fq;
#pragma unroll
        for (int ai = 0; ai < 2; ++ai)
#pragma unroll
            for (int m = 0; m < 4; ++m) { const int rt = ai * HALF + wr * 64 + m * 16 + fr;
                if (rt < u.nvalid) {
                    const int a = list[u.e * LISTCAP + u.pm * 256 + rt]; const float rs = rstd2[a >> 1];
                    float h[8];
#pragma unroll
                    for (int n = 0; n < 2; ++n)
#pragma unroll
                        for (int j = 0; j < 4; ++j) { const float g = acc[ai][0][m][n][j] * rs, up = acc[ai][1][m][n][j] * rs; h[n * 4 + j] = g * sigmoid_f(g) * up; }
                    u32x4 w; w.x = cvt_pk_bf16(h[0], h[1]); w.y = cvt_pk_bf16(h[2], h[3]); w.z = cvt_pk_bf16(h[4], h[5]); w.w = cvt_pk_bf16(h[6], h[7]);
                    *(u32x4*)(HM + (size_t)(u.rowbase + rt) * DEXP + col0) = w; } }
    }
};
struct EpiDown {
    static constexpr bool PERM = true;
    bf16_t* YT;
    __device__ __forceinline__ void operator()(const f32x4 (&acc)[2][2][4][2], const Unit& u, int wr, int wc, int fr, int fq) const {
        const int col0 = u.pn * BM + wc * 32 + 8 * fq;
#pragma unroll
        for (int ai = 0; ai < 2; ++ai)
#pragma unroll
            for (int m = 0; m < 4; ++m) { const int rt = ai * HALF + wr * 64 + m * 16 + fr; bf16_t* rowp = YT + (size_t)(u.rowbase + rt) * DM + col0;
                if (rt < u.nvalid) {
#pragma unroll
                for (int bj = 0; bj < 2; ++bj) { const f32x4 v0 = acc[ai][bj][m][0], v1 = acc[ai][bj][m][1];
                    u32x4 w; w.x = cvt_pk_bf16(v0[0], v0[1]); w.y = cvt_pk_bf16(v0[2], v0[3]); w.z = cvt_pk_bf16(v1[0], v1[1]); w.w = cvt_pk_bf16(v1[2], v1[3]);
                    *(u32x4*)(rowp + bj * HALF) = w; } } }
    }
};
}

#define XB_TMO      128
#define XB_XCNT(j)  (256  + 64 * (j))
#define XB_XSUB(j)  (1280 + 64 * (j))
#define XB_XGEN(j)  (2304 + 64 * (j))
#define XB_TOP      3328
#define XB_TOPGEN   3392
#define XCD_BAR_WORDS 3456
#define XB_SPIN_CAP (1u << 18)
__device__ __forceinline__ unsigned xb_ld(unsigned* p)              { return __hip_atomic_load(p, __ATOMIC_RELAXED, __HIP_MEMORY_SCOPE_AGENT); }
__device__ __forceinline__ unsigned xb_add(unsigned* p, unsigned v) { return __hip_atomic_fetch_add(p, v, __ATOMIC_RELAXED, __HIP_MEMORY_SCOPE_AGENT); }
__device__ __forceinline__ unsigned xb_xcc_id() { return (unsigned)__builtin_amdgcn_s_getreg((3 << 11) | 20) & 0xFu; }
#define XB_SPIN(cond, bar) do { unsigned _sp = 0; while (cond) { __builtin_amdgcn_s_sleep(1); \
    if ((++_sp & 255u) == 0u) { if (xb_ld(&(bar)[XB_TMO])) break; if (_sp > XB_SPIN_CAP) { atomicAdd(&(bar)[XB_TMO], 1u); break; } } } } while (0)
struct XcdBarrier { unsigned* bar; unsigned x; volatile LAS unsigned* st; };
__device__ __forceinline__ XcdBarrier xcd_barrier_post(unsigned* bar, volatile LAS unsigned* st) {
    XcdBarrier b; b.bar = bar; b.x = xb_xcc_id(); b.st = st;
    if (threadIdx.x == 0) (void)xb_add(&bar[XB_XCNT(b.x)], 1u);
    return b;
}
__device__ __forceinline__ void xcd_barrier_complete(unsigned* bar, unsigned x, unsigned& nloc, unsigned& nx) {
    const unsigned G = gridDim.x * gridDim.y * gridDim.z;
    unsigned sum, cnt, mine, sp = 0u;
    for (;;) {
        sum = 0u; cnt = 0u; mine = 0u;
#pragma unroll
        for (unsigned j = 0; j < 16; ++j) { const unsigned c = xb_ld(&bar[XB_XCNT(j)]); sum += c; cnt += (c > 0u) ? 1u : 0u; mine = (j == x) ? c : mine; }
        if (sum == G) break;
        __builtin_amdgcn_s_sleep(1);
        if ((++sp & 255u) == 0u) { if (xb_ld(&bar[XB_TMO])) break; if (sp > XB_SPIN_CAP) { atomicAdd(&bar[XB_TMO], 1u); break; } }
    }
    nloc = mine > 0u ? mine : 1u; nx = cnt > 0u ? cnt : 1u;
}
__device__ __forceinline__ void xcd_barrier(const XcdBarrier& b, const bool thread0) {
    asm volatile("s_waitcnt vmcnt(0)" ::: "memory");
    __syncthreads();
    if (thread0) {
        unsigned* bar = b.bar;
        __builtin_amdgcn_s_waitcnt(0);
        unsigned nloc = b.st[0], nx = b.st[1];
        if (nloc == 0u) { xcd_barrier_complete(bar, b.x, nloc, nx); b.st[0] = nloc; b.st[1] = nx; }
        const unsigned old = xb_add(&bar[XB_XSUB(b.x)], 1u);
        const unsigned gen = old / nloc;
        if (old + 1u == (gen + 1u) * nloc) {
            __builtin_amdgcn_fence(__ATOMIC_RELEASE, "agent");
            asm volatile("s_waitcnt vmcnt(0)" ::: "memory");
            const unsigned og = xb_add(&bar[XB_TOP], 1u);
            const unsigned tg = og / nx;
            if (og + 1u == (tg + 1u) * nx) xb_add(&bar[XB_TOPGEN], 1u);
            else XB_SPIN(xb_ld(&bar[XB_TOPGEN]) == tg, bar);
            __builtin_amdgcn_fence(__ATOMIC_ACQUIRE, "agent");
            xb_add(&bar[XB_XGEN(b.x)], 1u);
            asm volatile("s_waitcnt vmcnt(0)" ::: "memory");
        } else {
            XB_SPIN(xb_ld(&bar[XB_XGEN(b.x)]) == gen, bar);
            __builtin_amdgcn_fence(__ATOMIC_ACQUIRE, "agent");
            asm volatile("s_waitcnt vmcnt(0)" ::: "memory");
        }
    }
    __syncthreads();
}

struct Frame {
    LAS unsigned char* lds;
    unsigned* ctl;
    int tid, lane, wave, vcu, G;
    const float *x, *g1, *w_in, *gvn, *gsw, *gsb, *igb, *fgb, *ogn, *w_out, *g2, *rgw, *rgb, *rew, *reb, *wg, *wu, *wd, *gf;
    float* out;
    bf16_t *WIN_T, *WOUT_T, *WGU_T, *WD_T, *WRT, *ACT, *PROJ, *YT, *HM, *QH, *KH, *VH, *PM, *KP;
    float *GATES, *RSTD2, *AW, *HB, *VSSP, *GS, *GT; bf16_t* X1; int *LIST, *APOS;
};

struct TrDesc { const float* src; bf16_t* dst; int rk0; int ldw, ldt; };
__device__ __forceinline__ int gain_off(int k) { return (k >> 9) * 16640 + 8448 + 4 * (k & 511); }
__device__ __forceinline__ void tr_load(const TrDesc& d, f32x4 (&v)[16], int lane) {
    const GAS float* wp = (const GAS float*)d.src + (size_t)(lane >> 4) * d.ldw + 4 * (lane & 15);
#pragma unroll
    for (int i = 0; i < 16; ++i) v[i] = __builtin_nontemporal_load((const GAS f32x4*)(wp + (size_t)(4 * i) * d.ldw));
}
__device__ __forceinline__ void tr_store(const TrDesc& d, const f32x4 (&v)[16], LAS float* scr, int lane, LAS unsigned char* lds) {
    LAS unsigned* sw = (LAS unsigned*)scr + (lane >> 4) * 33 + 2 * (lane & 15);
    if (d.rk0 >= 0) { const LAS float* rs = (const LAS float*)(lds + gain_off(d.rk0)) + (lane >> 4);
#pragma unroll
        for (int i = 0; i < 16; ++i) { const float s = rs[4 * i]; sw[(4 * i) * 33 + 0] = cvtpk(v[i].x * s, v[i].y * s); sw[(4 * i) * 33 + 1] = cvtpk(v[i].z * s, v[i].w * s); } }
    else {
#pragma unroll
        for (int i = 0; i < 16; ++i) { sw[(4 * i) * 33 + 0] = cvtpk(v[i].x, v[i].y); sw[(4 * i) * 33 + 1] = cvtpk(v[i].z, v[i].w); } }
    LDS_WAIT();
    const int c = lane & 7;
#pragma unroll
    for (int j = 0; j < 4; ++j) { const int dcol = (lane >> 3) + 8 * j; const LAS unsigned* sr = (const LAS unsigned*)scr + (8 * c) * 33 + dcol;
        unsigned x[8];
#pragma unroll
        for (int kk = 0; kk < 8; ++kk) x[kk] = sr[kk * 33];
        u32x4 lo, hi;
        lo.x = (x[0] & 0xffffu) | (x[1] << 16); lo.y = (x[2] & 0xffffu) | (x[3] << 16); lo.z = (x[4] & 0xffffu) | (x[5] << 16); lo.w = (x[6] & 0xffffu) | (x[7] << 16);
        hi.x = (x[0] >> 16) | (x[1] & 0xffff0000u); hi.y = (x[2] >> 16) | (x[3] & 0xffff0000u); hi.z = (x[4] >> 16) | (x[5] & 0xffff0000u); hi.w = (x[6] >> 16) | (x[7] & 0xffff0000u);
        GAS bf16_t* op = (GAS bf16_t*)d.dst + (size_t)(2 * dcol) * d.ldt + 8 * c;
        __builtin_nontemporal_store(lo, (GAS u32x4*)op); __builtin_nontemporal_store(hi, (GAS u32x4*)(op + d.ldt)); }
    LDS_WAIT();
}
__device__ __forceinline__ void phase0_gt(Frame& F) {
    const int per = (4096 + F.G - 1) / F.G, k0 = F.vcu * per;
    for (int idx = F.tid; idx < per * 8; idx += 512) { const int k = k0 + (idx >> 3), j = idx & 7; if (k < 4096) F.GT[j * 4096 + k] = F.g1[k] * F.w_in[(size_t)k * LDW_IN + NPROJ + j]; }
}
__device__ __forceinline__ void phase0(Frame& F) {
    LAS float* gwl = (LAS float*)F.lds;
    { const f32x4* gt = (const f32x4*)F.GT;
#pragma unroll
      for (int i = 0; i < 16; ++i) *(LAS f32x4*)(gwl + 4 * (F.tid + 512 * i)) = gt[F.tid + 512 * i]; }
    __syncthreads();
    const int gw = F.vcu * 8 + F.wave, NGW = F.G * 8;
    for (int m = gw; m < NTOK; m += NGW) {
        const f32x4* xr = (const f32x4*)(F.x + (size_t)m * DM) + F.lane;
        const f32x4* gr = (const f32x4*)F.g1 + F.lane;
        asm volatile("" : "+v"(gr));
        f32x4 v[16];
#pragma unroll
        for (int j = 0; j < 16; ++j) v[j] = xr[64 * j];
        const LAS float* l0 = gwl + 4 * F.lane; const LAS float* l1 = l0 + 4 * 4096;
        asm volatile("" : "+v"(l0), "+v"(l1));
        float ss = 0.f; float ga[8];
#pragma unroll
        for (int c = 0; c < 8; ++c) ga[c] = 0.f;
#pragma unroll
        for (int j = 0; j < 16; ++j) { const f32x4 y = v[j]; ss += (y.x * y.x + y.y * y.y) + (y.z * y.z + y.w * y.w);
#pragma unroll
            for (int c = 0; c < 4; ++c) { const f32x4 w = *(const LAS f32x4*)(l0 + 256 * j + c * 4096); ga[c] += (y.x * w.x + y.y * w.y) + (y.z * w.z + y.w * w.w); }
#pragma unroll
            for (int c = 0; c < 4; ++c) { const f32x4 w = *(const LAS f32x4*)(l1 + 256 * j + c * 4096); ga[4 + c] += (y.x * w.x + y.y * w.y) + (y.z * w.z + y.w * w.w); }
            }
        ss = wave_sum(ss);
        const float rstd = 1.0f / sqrtf(ss * (1.0f / DM) + EPS);
#pragma unroll
        for (int c = 0; c < 8; ++c) ga[c] = wave_sum(ga[c]) * rstd;
        if (F.lane == 0) { f32x4* gp = (f32x4*)(F.GATES + (size_t)m * 8); gp[0] = (f32x4){ga[0], ga[1], ga[2], ga[3]}; gp[1] = (f32x4){ga[4], ga[5], ga[6], ga[7]}; }
        u32x2* o8 = (u32x2*)(F.ACT + (size_t)m * DM) + F.lane;
#pragma unroll
        for (int j = 0; j < 16; ++j) { const f32x4 y = v[j] * rstd * gr[64 * j]; u32x2 o; o.x = cvtpk(y.x, y.y); o.y = cvtpk(y.z, y.w); o8[64 * j] = o; }
    }
    __syncthreads();
}
constexpr int I_IN = 64 * 160, I_OUT = 64 * 64, I_G = 64 * 512, I_U = I_G, I_D = 64 * 512;
constexpr int NITEMS = I_IN + I_OUT + I_G + I_U + I_D, ITEMS_DENSE = I_IN;
constexpr int NCONV = 72;
__device__ __forceinline__ void phase_convert(Frame& F, const int it_lo, const int it_hi, const int gw, const int NGW) {
    LAS float* scr = (LAS float*)(F.lds + F.wave * 16640);
    if (it_hi > ITEMS_DENSE + I_OUT) { __syncthreads(); for (int k = F.tid; k < DM; k += 512) *(LAS float*)(F.lds + gain_off(k)) = F.g2[k]; __syncthreads(); }
    auto decode = [&](int it) -> TrDesc {
        TrDesc d; int r = it;
        if (r < I_IN) { const int kb = r & 63, nb = r >> 6;   d.src = F.w_in + (size_t)(64 * kb) * LDW_IN + 64 * nb; d.rk0 = -1; d.ldw = LDW_IN; d.dst = F.WIN_T + (size_t)(64 * nb) * DM + 64 * kb; d.ldt = DM; return d; } r -= I_IN;
        if (r < I_OUT) { const int kb = r & 63, nb = r >> 6; d.src = F.w_out + (size_t)(64 * kb) * DM + 64 * nb; d.rk0 = -1; d.ldw = DM; d.dst = F.WOUT_T + (size_t)(64 * nb) * DM + 64 * kb; d.ldt = DM; return d; } r -= I_OUT;
        if (r < I_G + I_U) { const int up = (r >= I_G) ? 1 : 0; r -= up * I_G; const int e = r >> 9, q = r & 511, kb = (q >> 6) * 8 + (q & 7), n0 = ((q >> 3) & 7) * 64; const int drow = (n0 >> 7) * 256 + up * 128 + (n0 & 127);
            d.src = (up ? F.wu : F.wg) + (size_t)e * DM * DEXP + (size_t)(64 * kb) * DEXP + n0; d.rk0 = 64 * kb; d.ldw = DEXP; d.dst = F.WGU_T + (size_t)e * 1024 * DM + (size_t)drow * DM + 64 * kb; d.ldt = DM; return d; } r -= I_G + I_U;
        { const int e = r >> 9, q = r & 511, kb = q & 7, nb = q >> 3;
            d.src = F.wd + (size_t)e * DEXP * DM + (size_t)(64 * kb) * DM + 64 * nb; d.rk0 = -1; d.ldw = DM; d.dst = F.WD_T + (size_t)e * DM * DEXP + (size_t)(64 * nb) * DEXP + 64 * kb; d.ldt = DEXP; return d; }
    };
    if (NGW < 0) {
        const int per = (it_hi - it_lo + (-NGW) - 1) / (-NGW); int it = it_lo + gw * per; const int ie = (it + per < it_hi) ? it + per : it_hi;
        f32x4 va[16], vb[16], vc[16]; TrDesc da, db, dc;
        if (it < ie) { da = decode(it); tr_load(da, va, F.lane); }
        if (it + 1 < ie) { db = decode(it + 1); tr_load(db, vb, F.lane); }
        for (; it < ie; it += 3) {
            if (it + 2 < ie) { dc = decode(it + 2); tr_load(dc, vc, F.lane); }
            tr_store(da, va, scr, F.lane, F.lds);
            if (it + 1 >= ie) break;
            if (it + 3 < ie) { da = decode(it + 3); tr_load(da, va, F.lane); }
            tr_store(db, vb, scr, F.lane, F.lds);
            if (it + 2 >= ie) break;
            if (it + 4 < ie) { db = decode(it + 4); tr_load(db, vb, F.lane); }
            tr_store(dc, vc, scr, F.lane, F.lds);
        }
        return; }
    { f32x4 va[16], vb[16]; TrDesc d0, d1; int it = it_lo + gw;
      if (it < it_hi) { d0 = decode(it); tr_load(d0, va, F.lane); }
      for (; it < it_hi; it += NGW) {
          const bool has = (it + NGW) < it_hi;
          if (has) { d1 = decode(it + NGW); tr_load(d1, vb, F.lane); }
          tr_store(d0, va, scr, F.lane, F.lds);
          if (has) { d0 = d1;
#pragma unroll
              for (int i = 0; i < 16; ++i) va[i] = vb[i]; }
      } }
}
__device__ __forceinline__ void phase0b(Frame& F) {
    phase_convert(F, 0, ITEMS_DENSE, F.vcu * 8 + F.wave, F.G * 8);
#pragma unroll 2
    for (int idx = F.vcu * 512 + F.tid; idx < 80 * 4096; idx += F.G * 512) { const int n = idx >> 12, k = idx & 4095;
        const float v = (n < 8) ? F.rgw[k * 8 + n] : ((n < 72) ? F.rew[k * 64 + (n - 8)] : 0.f); F.WRT[idx] = (bf16_t)f2bf(v * F.g2[k]); }
}

typedef short v4i16_t __attribute__((ext_vector_type(4)));
__device__ __forceinline__ bf16x8 tr_bfrag(const LAS bf16_t* p0, const LAS bf16_t* p1) {
    const v4i16_t a = __builtin_amdgcn_ds_read_tr16_b64_v4i16((LAS v4i16_t*)p0), b = __builtin_amdgcn_ds_read_tr16_b64_v4i16((LAS v4i16_t*)p1);
    bf16x8 o; o[0] = a[0]; o[1] = a[1]; o[2] = a[2]; o[3] = a[3]; o[4] = b[0]; o[5] = b[1]; o[6] = b[2]; o[7] = b[3]; return o;
}
__device__ __forceinline__ void phase_gmlp(Frame& F) {
    LAS bf16_t* Wl = (LAS bf16_t*)(F.lds);
    LAS bf16_t* VT = (LAS bf16_t*)(F.lds + 34816);
    LAS float* rs = (LAS float*)(F.lds + 69632);
    LAS float* Zt = (LAS float*)(F.lds + 70144);
    const int r = F.lane & 15, g4 = F.lane >> 4;
    for (int unit = blockIdx.x; unit < 512; unit += F.G) {
        const int g = unit & 15, cb = unit >> 4;
#pragma unroll
        for (int i = 0; i < 8; ++i) { const int idx = F.tid + 512 * i, t = idx >> 5, sc = (idx & 31) * 4;
            f32x4 w = *(const f32x4*)(F.gsw + (size_t)g * 16384 + t * 128 + sc);
            w.x = (sc + 0 <= t) ? w.x : 0.f; w.y = (sc + 1 <= t) ? w.y : 0.f; w.z = (sc + 2 <= t) ? w.z : 0.f; w.w = (sc + 3 <= t) ? w.w : 0.f;
            u32x2 o; o.x = cvtpk(w.x, w.y); o.y = cvtpk(w.z, w.w); *(LAS u32x2*)(Wl + t * 136 + sc) = o; }
        u32x4 vraw[4], uraw[4]; f32x4 pp[8];
#define GM_PREFETCH_V(chn) do { const int r0n = (4 * cb + (chn)) * 128; \
            _Pragma("unroll") for (int i = 0; i < 4; ++i) { const int idx_ = F.tid + 512 * i; vraw[i] = *(const u32x4*)(F.PROJ + (size_t)(r0n + (idx_ >> 4)) * NPROJ + C_V + g * 128 + (idx_ & 15) * 8); } \
            if (F.tid < 128) { const f32x4* pq = (const f32x4*)(F.VSSP + (size_t)(r0n + F.tid) * 32); _Pragma("unroll") for (int q = 0; q < 8; ++q) pp[q] = pq[q]; } } while (0)
        GM_PREFETCH_V(0);
        LDS_BARRIER();
#pragma unroll
        for (int ch = 0; ch < 4; ++ch) {
            const int r0 = (4 * cb + ch) * 128;
            if (F.tid < 128) { float ss = 0.f;
#pragma unroll
                for (int q = 0; q < 8; ++q) ss += (pp[q].x + pp[q].y) + (pp[q].z + pp[q].w);
                rs[F.tid] = 1.0f / sqrtf(ss * (1.0f / 2048.0f) + EPS); }
            LDS_BARRIER();
            { const int d8 = (F.tid & 15) * 8;
              const f32x4 gva = *(const f32x4*)(F.gvn + g * 128 + d8), gvb = *(const f32x4*)(F.gvn + g * 128 + d8 + 4);
#pragma unroll
              for (int i = 0; i < 4; ++i) { const int t = (F.tid >> 4) + 32 * i; const float scl = rs[t];
                const u32x4 raw = vraw[i]; const f32x4 ga = gva * scl, gb = gvb * scl;
                u32x4 o; o.x = cvtpk(bf_lo(raw.x) * ga.x, bf_hi(raw.x) * ga.y); o.y = cvtpk(bf_lo(raw.y) * ga.z, bf_hi(raw.y) * ga.w); o.z = cvtpk(bf_lo(raw.z) * gb.x, bf_hi(raw.z) * gb.y); o.w = cvtpk(bf_lo(raw.w) * gb.z, bf_hi(raw.w) * gb.w);
                *(LAS u32x4*)(VT + t * 136 + d8) = o; } }
#pragma unroll
            for (int i = 0; i < 4; ++i) { const int idx = F.tid + 512 * i; uraw[i] = *(const u32x4*)(F.PROJ + (size_t)(r0 + (idx >> 4)) * NPROJ + C_U + g * 128 + (idx & 15) * 8); }
            if (ch + 1 < 4) GM_PREFETCH_V(ch + 1);
            LDS_BARRIER();
            const int t0 = 16 * F.wave, nks = (F.wave >> 1) + 1;
            f32x4 acc[8];
#pragma unroll
            for (int dt = 0; dt < 8; ++dt) acc[dt] = (f32x4){0.f, 0.f, 0.f, 0.f};
            for (int ks = 0; ks < nks; ++ks) {
                const bf16x8 A = *(const LAS bf16x8*)(Wl + (t0 + r) * 136 + 32 * ks + 8 * g4);
                bf16x8 B[8];
#pragma unroll
                for (int dt = 0; dt < 8; ++dt) { const LAS bf16_t* bp = VT + (32 * ks + 8 * g4 + (r >> 2)) * 136 + 16 * dt + 4 * (r & 3); B[dt] = tr_bfrag(bp, bp + 4 * 136); }
                __builtin_amdgcn_sched_barrier(0);
#pragma unroll
                for (int dt = 0; dt < 8; ++dt) acc[dt] = mfma16(A, B[dt], acc[dt]);
                __builtin_amdgcn_sched_barrier(0); }
#pragma unroll
            for (int rr = 0; rr < 4; ++rr) { const int t = t0 + 4 * g4 + rr; const float bias = F.gsb[g * 128 + t];
#pragma unroll
                for (int dt = 0; dt < 8; ++dt) Zt[t * 132 + 16 * dt + r] = acc[dt][rr] + bias; }
            LDS_BARRIER();
#pragma unroll
            for (int i = 0; i < 4; ++i) { const int idx = F.tid + 512 * i, t = idx >> 4, d8 = (idx & 15) * 8;
                const u32x4 uu = uraw[i];
                const f32x4 z0 = *(const LAS f32x4*)(Zt + t * 132 + d8), z1 = *(const LAS f32x4*)(Zt + t * 132 + d8 + 4);
                u32x4 o; o.x = cvtpk(bf_lo(uu.x) * z0.x, bf_hi(uu.x) * z0.y); o.y = cvtpk(bf_lo(uu.y) * z0.z, bf_hi(uu.y) * z0.w); o.z = cvtpk(bf_lo(uu.z) * z1.x, bf_hi(uu.z) * z1.y); o.w = cvtpk(bf_lo(uu.w) * z1.z, bf_hi(uu.w) * z1.w);
                *(u32x4*)(F.ACT + (size_t)(r0 + t) * DM + g * 128 + d8) = o; }
        }
#undef GM_PREFETCH_V
        __syncthreads();
    }
}

__device__ __forceinline__ float softcap15(float z) { return 15.0f * tanhf(z * (1.0f / 15.0f)); }
__device__ __forceinline__ void phase_gates(Frame& F, const int bh) {
    LAS float* SA = (LAS float*)(F.lds);
    LAS float* SM = (LAS float*)(F.lds + 16384);
    LAS float* SFL = (LAS float*)(F.lds + 32768);
    LAS float* scr = (LAS float*)(F.lds + 134144);
    const int tid = F.tid, lane = F.lane, wave = F.wave, b = bh >> 2, hh = bh & 3, rowb = b * SEQL;
    __syncthreads();
        { const float igb = F.igb[hh], fgb = F.fgb[hh];
          float cs[8], av[8]; float run = 0.f;
          float gi8[8], gf8[8];
#pragma unroll
          for (int k = 0; k < 8; ++k) { const float* gp = F.GATES + (size_t)(rowb + 8 * tid + k) * 8; gi8[k] = gp[hh]; gf8[k] = gp[4 + hh]; }
#pragma unroll
          for (int k = 0; k < 8; ++k) { const float zf = softcap15(gf8[k] + fgb); run += -log1pf(expf(-zf)); cs[k] = run; av[k] = softcap15(gi8[k] + igb); }
          float incl = run;
#pragma unroll
          for (int o = 1; o < 64; o <<= 1) { const float t = __shfl_up(incl, o); if (lane >= o) incl += t; }
          if (lane == 63) scr[wave] = incl;
          __syncthreads();
          float base = incl - run;
          for (int w = 0; w < wave; ++w) base += scr[w];
          float Bv[8]; float runm = -3.0e38f; float mx[8];
#pragma unroll
          for (int k = 0; k < 8; ++k) { Bv[k] = base + cs[k]; av[k] = av[k] - Bv[k]; runm = fmaxf(runm, av[k]); mx[k] = runm; }
          float inclm = runm;
#pragma unroll
          for (int o = 1; o < 64; o <<= 1) { const float t = __shfl_up(inclm, o); if (lane >= o) inclm = fmaxf(inclm, t); }
          float exclm = __shfl_up(inclm, 1); if (lane == 0) exclm = -3.0e38f;
          if (lane == 63) scr[8 + wave] = inclm;
          __syncthreads();
          float basem = fmaxf(0.f, exclm);
          for (int w = 0; w < wave; ++w) basem = fmaxf(basem, scr[8 + w]);
          float Mv[8], flv[8];
#pragma unroll
          for (int k = 0; k < 8; ++k) { Mv[k] = fmaxf(basem, mx[k]); flv[k] = expf(-(Bv[k] + Mv[k])); }
          *(LAS f32x4*)(SA + 8 * tid) = (f32x4){av[0], av[1], av[2], av[3]}; *(LAS f32x4*)(SA + 8 * tid + 4) = (f32x4){av[4], av[5], av[6], av[7]};
          *(LAS f32x4*)(SM + 8 * tid) = (f32x4){Mv[0], Mv[1], Mv[2], Mv[3]}; *(LAS f32x4*)(SM + 8 * tid + 4) = (f32x4){Mv[4], Mv[5], Mv[6], Mv[7]};
          *(LAS f32x4*)(SFL + 8 * tid) = (f32x4){flv[0], flv[1], flv[2], flv[3]}; *(LAS f32x4*)(SFL + 8 * tid + 4) = (f32x4){flv[4], flv[5], flv[6], flv[7]}; }
    __syncthreads();
    { f32x4* gs = (f32x4*)(F.GS + (size_t)bh * 3 * 4096);
#pragma unroll
      for (int i = 0; i < 6; ++i) gs[tid + 512 * i] = *(const LAS f32x4*)(SA + 4 * (tid + 512 * i)); }
    __syncthreads();
}
__device__ __forceinline__ void phase_mlstm_pre(Frame& F) {
    LAS bf16_t* Kc = (LAS bf16_t*)(F.lds);
    LAS bf16_t* Qc = (LAS bf16_t*)(F.lds + 67584);
    const int wave = F.wave, pp = (wave < 4) ? wave : 7 - wave, hi = wave >> 2;
    for (int unit = F.vcu; unit < 256; unit += F.G) {
        const int bh = unit >> 4, es = unit & 15;
        int ln_ = F.lane; asm volatile("" : "+v"(ln_));
        const int r = ln_ & 15, g4 = ln_ >> 4, tid = wave * 64 + ln_;
        const float* ga = F.GS + (size_t)bh * 3 * 4096; const float* gm = ga + 4096;
        u32x4 kreg[8], qreg[8];
#define MP_LOAD(c) do { const char* kb_ = (const char*)(F.KH + (size_t)bh * SEQL * 256) + (size_t)(c) * 65536; const char* qb_ = (const char*)(F.QH + (size_t)bh * SEQL * 256) + (size_t)(c) * 65536; \
        _Pragma("unroll") for (int i = 0; i < 8; ++i) { kreg[i] = *(const u32x4*)(kb_ + 8192 * i + 16u * (unsigned)tid); qreg[i] = *(const u32x4*)(qb_ + 8192 * i + 16u * (unsigned)tid); } } while (0)
        MP_LOAD(es * 2);
        for (int t = 0; t < 2; ++t) {
            const int c = es * 2 + t, pb = 128 * c;
            char* kp_ = (char*)(F.KP + (size_t)bh * SEQL * 256) + (size_t)c * 65536;
            const float Mend = gm[pb + 127];
            __syncthreads();
#pragma unroll
            for (int i = 0; i < 8; ++i) { const int rowo = 16 * i;
                *(LAS u32x4*)(Kc + (tid >> 5) * 264 + 8 * (tid & 31) + rowo * 264) = kreg[i]; *(LAS u32x4*)(Qc + (tid >> 5) * 264 + 8 * (tid & 31) + rowo * 264) = qreg[i];
                const float wt = fast_exp(ga[pb + (tid >> 5) + rowo] - Mend); u32x4 kw;
                kw.x = cvtpk(bf_lo(kreg[i].x) * wt, bf_hi(kreg[i].x) * wt); kw.y = cvtpk(bf_lo(kreg[i].y) * wt, bf_hi(kreg[i].y) * wt); kw.z = cvtpk(bf_lo(kreg[i].z) * wt, bf_hi(kreg[i].z) * wt); kw.w = cvtpk(bf_lo(kreg[i].w) * wt, bf_hi(kreg[i].w) * wt);
                *(u32x4*)(kp_ + 8192 * i + 16u * (unsigned)tid) = kw; }
            LDS_BARRIER();
            if (t == 0) MP_LOAD(c + 1);
#pragma unroll
            for (int part = 0; part < 2; ++part) {
                const int rt = part ? 7 - pp : pp;
                const int jlo = part ? (hi ? 4 - pp : 0) : 0, jhi = part ? (hi ? 7 - pp : 3 - pp) : (hi ? -1 : pp);
                if (jlo <= jhi) {
                    const int i0 = 16 * rt;
                    bf16x8 Qf[8];
#pragma unroll
                    for (int ks = 0; ks < 8; ++ks) Qf[ks] = *(const LAS bf16x8*)(Qc + (i0 + r) * 264 + 32 * ks + 8 * g4);
                    bf16_t* Pg = F.PM + ((size_t)bh * 32 + c) * 16384 + (size_t)(i0 + r) * 128 + 4 * g4;
                    const float Mi = gm[pb + i0 + r]; const int irow = i0 + r;
                    for (int jt = jlo; jt <= jhi; ++jt) {
                        bf16x8 Kf[8];
#pragma unroll
                        for (int ks = 0; ks < 8; ++ks) Kf[ks] = *(const LAS bf16x8*)(Kc + (16 * jt + r) * 264 + 32 * ks + 8 * g4);
                        const f32x4 a4 = *(const f32x4*)(ga + pb + 16 * jt + 4 * g4);
                        __builtin_amdgcn_sched_barrier(0);
                        f32x4 sv = (f32x4){0.f, 0.f, 0.f, 0.f};
#pragma unroll
                        for (int ks = 0; ks < 8; ++ks) sv = mfma16(Kf[ks], Qf[ks], sv);
                        __builtin_amdgcn_sched_barrier(0);
                        float p[4];
#pragma unroll
                        for (int rr = 0; rr < 4; ++rr) p[rr] = (16 * jt + 4 * g4 + rr <= irow) ? sv[rr] * fast_exp(a4[rr] - Mi) : 0.f;
                        u32x2 w; w.x = cvtpk(p[0], p[1]); w.y = cvtpk(p[2], p[3]);
                        *(u32x2*)(Pg + 16 * jt) = w; }
                    if (jhi == rt && (rt & 1) == 0) *(u32x2*)(Pg + 16 * (rt + 1)) = (u32x2){0u, 0u};
                } }
        }
#undef MP_LOAD
    }
    __syncthreads();
}
__device__ __forceinline__ void phase_mlstm(Frame& F) {
    LAS float* SM = (LAS float*)(F.lds);
    LAS float* SFL = (LAS float*)(F.lds + 16384);
    LAS bf16_t* Kc = (LAS bf16_t*)(F.lds + 32768);
    LAS bf16_t* CT = (LAS bf16_t*)(F.lds + 100352);
    LAS bf16_t* NV = (LAS bf16_t*)(F.lds + 117248);
    LAS bf16_t* Vc = (LAS bf16_t*)(F.lds + 117760);
    const int wave = F.wave;
    const int rt = (wave < 4) ? wave : 11 - wave, i0 = 16 * rt, nks = (rt >> 1) + 1, et = wave >> 2, dq = wave & 3;
    for (int unit = F.vcu; unit < 256; unit += F.G) {
        const int b = unit >> 6, hh = (unit >> 4) & 3, es = unit & 15, e0 = es * 32, bh = b * 4 + hh;
        const int rowb = b * SEQL;
        int ln_ = F.lane; asm volatile("" : "+v"(ln_));
        const int r = ln_ & 15, g4 = ln_ >> 4, tid = wave * 64 + ln_;
        __syncthreads();
        { const f32x4* gs = (const f32x4*)(F.GS + (size_t)bh * 3 * 4096 + 4096);
#pragma unroll
          for (int i = 0; i < 4; ++i) *(LAS f32x4*)(SM + 4 * (tid + 512 * i)) = gs[tid + 512 * i]; }
        for (int idx = tid; idx < 32 * 264; idx += 512) CT[idx] = 0;
        if (tid < 256) NV[tid] = 0;
        __syncthreads();
        const char* Kp = (const char*)(F.KP + (size_t)bh * SEQL * 256); const unsigned kvo = 16u * (unsigned)tid;
        const char* Vp = (const char*)(F.VH + (size_t)bh * SEQL * 512 + e0); const unsigned vvo = (unsigned)((tid >> 2) * 1024 + (tid & 3) * 16);
        const char* Qp = (const char*)(F.QH + (size_t)bh * SEQL * 256) + i0 * 512; const unsigned qvo = (unsigned)(r * 512 + 16 * g4);
        const char* Pp = (const char*)(F.PM + (size_t)bh * 32 * 16384) + i0 * 256; const unsigned pvo = (unsigned)(r * 256 + 16 * g4);
        f32x4 accC[4], accN[4];
#pragma unroll
        for (int dd = 0; dd < 4; ++dd) { accC[dd] = (f32x4){0.f, 0.f, 0.f, 0.f}; accN[dd] = (f32x4){0.f, 0.f, 0.f, 0.f}; }
        u32x4 kreg[8], vreg, Qr[8], Pr[4];
#pragma unroll
        for (int ks = 0; ks < 4; ++ks) Pr[ks] = (u32x4){0u, 0u, 0u, 0u};
#define ML_LOADKV(c) do { const char* kb_ = Kp + (size_t)(c) * 65536; _Pragma("unroll") for (int i = 0; i < 8; ++i) kreg[i] = *(const u32x4*)(kb_ + 8192 * i + kvo); vreg = *(const u32x4*)(Vp + (size_t)(c) * 131072 + vvo); } while (0)
#define ML_LOADQ(c) do { const char* qb_ = Qp + (size_t)(c) * 65536; _Pragma("unroll") for (int ks = 0; ks < 8; ++ks) Qr[ks] = *(const u32x4*)(qb_ + 64 * ks + qvo); } while (0)
#define ML_LOADP(c) do { const char* pb_ = Pp + (size_t)(c) * 32768; _Pragma("unroll") for (int ks = 0; ks < 4; ++ks) if (ks < nks) Pr[ks] = *(const u32x4*)(pb_ + 64 * ks + pvo); } while (0)
        ML_LOADKV(0); ML_LOADQ(0); ML_LOADP(0);
        __builtin_amdgcn_s_waitcnt(0);
        for (int c = 0; c < 32; ++c) {
            const int pb = 128 * c;
#pragma unroll
            for (int i = 0; i < 8; ++i) *(LAS u32x4*)(Kc + (tid >> 5) * 264 + 8 * (tid & 31) + i * (16 * 264)) = kreg[i];
            *(LAS u32x4*)(Vc + (tid >> 2) * 48 + 8 * (tid & 3)) = vreg;
            LDS_BARRIER();
            if (c + 1 < 32) { ML_LOADKV(c + 1); }
            const float Rc = (c == 0) ? 0.f : SM[pb - 1]; const float Rn = SM[pb + 127]; const float decay = fast_exp(Rc - Rn);
            const bf16x8 ones = (bf16x8){(short)0x3f80, (short)0x3f80, (short)0x3f80, (short)0x3f80, (short)0x3f80, (short)0x3f80, (short)0x3f80, (short)0x3f80};
            {
#pragma unroll
              for (int dd = 0; dd < 4; ++dd) { accC[dd] = accC[dd] * decay; accN[dd] = accN[dd] * decay; }
#pragma unroll
              for (int ks = 0; ks < 4; ++ks) { bf16x8 Kb[4];
                  const LAS bf16_t* wp = Vc + (32 * ks + 8 * g4 + (r >> 2)) * 48 + 16 * et + 4 * (r & 3); const bf16x8 Aw = tr_bfrag(wp, wp + 4 * 48);
                  const LAS bf16_t* kp = Kc + (32 * ks + 8 * g4 + (r >> 2)) * 264 + 64 * dq + 4 * (r & 3);
#pragma unroll
                  for (int dd = 0; dd < 4; ++dd) Kb[dd] = tr_bfrag(kp + 16 * dd, kp + 4 * 264 + 16 * dd);
#pragma unroll
                  for (int dd = 0; dd < 4; ++dd) accC[dd] = mfma16(Kb[dd], Aw, accC[dd]);
                  if (et == 0) {
#pragma unroll
                      for (int dd = 0; dd < 4; ++dd) accN[dd] = mfma16(Kb[dd], ones, accN[dd]); } }
            }
            __builtin_amdgcn_sched_barrier(0);
            bf16x8 R[8];
#pragma unroll
            for (int ks = 0; ks < 8; ++ks) R[ks] = *(const LAS bf16x8*)(CT + r * 264 + 32 * ks + 8 * g4);
            f32x4 o1a = (f32x4){0.f, 0.f, 0.f, 0.f}, o1b = o1a, o2a = o1a, o2b = o1a, qn = o1a, dsum = o1a;
            __builtin_amdgcn_sched_barrier(0);
#define ML_SEG(MF, NEXTREAD) do { _Pragma("unroll") for (int ks = 0; ks < 8; ++ks) { MF; NEXTREAD; __builtin_amdgcn_sched_barrier(0); } } while (0)
            ML_SEG(o2a = mfma16(__builtin_bit_cast(bf16x8, Qr[ks]), R[ks], o2a), R[ks] = *(const LAS bf16x8*)(CT + (16 + r) * 264 + 32 * ks + 8 * g4));
            ML_SEG(o2b = mfma16(__builtin_bit_cast(bf16x8, Qr[ks]), R[ks], o2b), R[ks] = *(const LAS bf16x8*)(NV + 32 * ks + 8 * g4));
            { const LAS bf16_t* vp = Vc + (8 * g4 + (r >> 2)) * 48 + 4 * (r & 3);
#pragma unroll
              for (int ks = 0; ks < 4; ++ks) if (ks < nks) { const bf16x8 Ap = __builtin_bit_cast(bf16x8, Pr[ks]);
                  const bf16x8 Bva = tr_bfrag(vp + 32 * ks * 48, vp + (32 * ks + 4) * 48), Bvb = tr_bfrag(vp + 32 * ks * 48 + 16, vp + (32 * ks + 4) * 48 + 16);
                  o1a = mfma16(Ap, Bva, o1a); o1b = mfma16(Ap, Bvb, o1b); dsum = mfma16(Ap, ones, dsum); } }
            __builtin_amdgcn_sched_barrier(0);
            if (c + 1 < 32) { ML_LOADP(c + 1); }
            ML_SEG(qn = mfma16(__builtin_bit_cast(bf16x8, Qr[ks]), R[ks], qn), (void)0);
#undef ML_SEG
            __builtin_amdgcn_sched_barrier(0);
            if (c + 1 < 32) { ML_LOADQ(c + 1); }
            { const f32x4 Mi4 = *(const LAS f32x4*)(SM + pb + i0 + 4 * g4), fl4 = *(const LAS f32x4*)(SFL + pb + i0 + 4 * g4);
              char* hb_ = (char*)(F.HB + (size_t)(rowb + pb + i0) * 2048 + hh * 512 + e0); const unsigned hvoff = (unsigned)(4 * g4) * 8192u + 4u * (unsigned)r;
#pragma unroll
              for (int rr = 0; rr < 4; ++rr) { const float wir = fast_exp(Rc - Mi4[rr]);
                  const float den = wir * qn[rr] + dsum[rr]; const float inv = __builtin_amdgcn_rcpf(fmaxf(fabsf(den), fl4[rr]));
                  *(float*)(hb_ + (hvoff + 8192u * rr)) = (o1a[rr] + wir * o2a[rr]) * inv; *(float*)(hb_ + (hvoff + 8192u * rr) + 64) = (o1b[rr] + wir * o2b[rr]) * inv; } }
            {
              LDS_BARRIER();
#pragma unroll
              for (int dd = 0; dd < 4; ++dd) { u32x2 cw; cw.x = cvtpk(accC[dd][0], accC[dd][1]); cw.y = cvtpk(accC[dd][2], accC[dd][3]);
                  *(LAS u32x2*)(CT + (16 * et + r) * 264 + 16 * (4 * dq + dd) + 4 * g4) = cw; }
              if (et == 0 && r == 0) {
#pragma unroll
                  for (int dd = 0; dd < 4; ++dd) { u32x2 nw; nw.x = cvtpk(accN[dd][0], accN[dd][1]); nw.y = cvtpk(accN[dd][2], accN[dd][3]); *(LAS u32x2*)(NV + 16 * (4 * dq + dd) + 4 * g4) = nw; } } }
        }
#undef ML_LOADKV
#undef ML_LOADQ
#undef ML_LOADP
        __syncthreads();
    }
}
__device__ __forceinline__ void phase_mlnorm(Frame& F) {
    const int gw = F.vcu * 8 + F.wave, NGW = F.G * 8;
    for (int m = gw; m < NTOK; m += NGW) {
#pragma unroll
        for (int hh = 0; hh < 4; ++hh) {
            const f32x4* hp = (const f32x4*)(F.HB + (size_t)m * 2048 + hh * 512) + F.lane;
            const f32x4 v0 = hp[0], v1 = hp[64];
            float ss = (v0.x * v0.x + v0.y * v0.y) + (v0.z * v0.z + v0.w * v0.w) + (v1.x * v1.x + v1.y * v1.y) + (v1.z * v1.z + v1.w * v1.w);
            ss = wave_sum(ss);
            const float rstd = 1.0f / sqrtf(ss * (1.0f / 512.0f) + EPS);
            const f32x4* gp = (const f32x4*)(F.ogn + hh * 512) + F.lane; const f32x4 g0 = gp[0], g1 = gp[64];
            const u32x2* op = (const u32x2*)(F.PROJ + (size_t)m * NPROJ + C_O + hh * 512) + F.lane; const u32x2 s0 = op[0], s1 = op[64];
            u32x2* yp = (u32x2*)(F.ACT + (size_t)m * DM + 2048 + hh * 512) + F.lane;
            u32x2 o;
            o.x = pk2(v0.x * rstd * g0.x * bf_lo(s0.x), v0.y * rstd * g0.y * bf_hi(s0.x)); o.y = pk2(v0.z * rstd * g0.z * bf_lo(s0.y), v0.w * rstd * g0.w * bf_hi(s0.y)); yp[0] = o;
            o.x = pk2(v1.x * rstd * g1.x * bf_lo(s1.x), v1.y * rstd * g1.y * bf_hi(s1.x)); o.y = pk2(v1.z * rstd * g1.z * bf_lo(s1.y), v1.w * rstd * g1.w * bf_hi(s1.y)); yp[64] = o;
        }
    }
}

__device__ __forceinline__ void phase_router(Frame& F) {
    const int lane = F.lane, tid = F.tid, r = lane & 15, g4 = lane >> 4, pair = F.wave >> 1, half = F.wave & 1;
    LAS unsigned char* Bb = F.lds;
    LAS float* lg = (LAS float*)(F.lds + 40960) + F.wave * (16 * 81 + 16);
    for (int task = F.vcu * 4 + pair; task < NTOK / 16; task += F.G * 4) {
        const int row0 = task * 16;
        const bf16_t* xrow = F.X1 + (size_t)(row0 + r) * DM + half * 64 + 8 * g4;
        const int rotc = (F.vcu * 5) & 31;
        f32x4 acc[5];
#pragma unroll
        for (int nt = 0; nt < 5; ++nt) acc[nt] = (f32x4){0.f, 0.f, 0.f, 0.f};
        float ss = 0.f;
        u32x4 bst[3], x0[2], x1[2], x2[2], x3[2];
#define RT_KC(cc) (((cc) + rotc) & 31)
#define RT_BLOAD(cc) do { const bf16_t* wp_ = F.WRT + (size_t)RT_KC(cc) * 128; _Pragma("unroll") for (int q = 0; q < 3; ++q) { const int gc = tid + 512 * q; \
            if (gc < 1280) bst[q] = *(const u32x4*)(wp_ + (size_t)(gc >> 4) * DM + (gc & 15) * 8); } } while (0)
#define RT_BWRITE(buf) do { _Pragma("unroll") for (int q = 0; q < 3; ++q) { const int gc = tid + 512 * q, rw = gc >> 4, ch = gc & 15; \
            if (gc < 1280) *(LAS u32x4*)(Bb + (buf) * 20480 + rw * 256 + ((ch ^ (rw & 15)) << 4)) = bst[q]; } } while (0)
#define RT_XLOAD(X, cc) do { const bf16_t* xp_ = xrow + (size_t)RT_KC(cc) * 128; X[0] = *(const u32x4*)(xp_); X[1] = *(const u32x4*)(xp_ + 32); } while (0)
#define RT_STEP(cc, X) do { const LAS unsigned char* bp_ = Bb + ((cc) & 1) * 20480 + r * 256; \
            bf16x8 bfr_[2][5]; \
            _Pragma("unroll") for (int u = 0; u < 2; ++u) { const int sl_ = ((((half * 2 + u) * 4 + g4) ^ r) << 4); \
                _Pragma("unroll") for (int nt = 0; nt < 5; ++nt) bfr_[u][nt] = *(const LAS bf16x8*)(bp_ + nt * 4096 + sl_); } \
            _Pragma("unroll") for (int u = 0; u < 2; ++u) { \
                const float a0 = bf_lo(X[u].x), a1 = bf_hi(X[u].x), a2 = bf_lo(X[u].y), a3 = bf_hi(X[u].y), a4 = bf_lo(X[u].z), a5 = bf_hi(X[u].z), a6 = bf_lo(X[u].w), a7 = bf_hi(X[u].w); \
                ss += ((a0 * a0 + a1 * a1) + (a2 * a2 + a3 * a3)) + ((a4 * a4 + a5 * a5) + (a6 * a6 + a7 * a7)); } \
            __builtin_amdgcn_sched_barrier(0); \
            _Pragma("unroll") for (int u = 0; u < 2; ++u) { const bf16x8 af = __builtin_bit_cast(bf16x8, X[u]); \
                _Pragma("unroll") for (int nt = 0; nt < 5; ++nt) acc[nt] = mfma16(af, bfr_[u][nt], acc[nt]); } \
            __builtin_amdgcn_sched_barrier(0); \
            if ((cc) + 4 < 32) RT_XLOAD(X, (cc) + 4); \
            if ((cc) + 1 < 32) { RT_BWRITE(((cc) + 1) & 1); if ((cc) + 2 < 32) RT_BLOAD((cc) + 2); } \
            LDS_BARRIER(); } while (0)
        __syncthreads();
        RT_BLOAD(0); RT_XLOAD(x0, 0); RT_XLOAD(x1, 1); RT_XLOAD(x2, 2); RT_XLOAD(x3, 3);
        RT_BWRITE(0); RT_BLOAD(1);
        LDS_BARRIER();
#pragma unroll 1
        for (int c0 = 0; c0 < 32; c0 += 4) { RT_STEP(c0, x0); RT_STEP(c0 + 1, x1); RT_STEP(c0 + 2, x2); RT_STEP(c0 + 3, x3); }
#undef RT_KC
#undef RT_BLOAD
#undef RT_BWRITE
#undef RT_XLOAD
#undef RT_STEP
        ss += __shfl_xor(ss, 16); ss += __shfl_xor(ss, 32);
#pragma unroll
        for (int nt = 0; nt < 5; ++nt)
#pragma unroll
            for (int rr = 0; rr < 4; ++rr) lg[(4 * g4 + rr) * 81 + 16 * nt + r] = acc[nt][rr];
        if (lane < 16) lg[16 * 81 + lane] = ss;
        __syncthreads();
        if (half == 0 && lane < 16) {
            const int token = row0 + lane; const LAS float* lr = lg + lane * 81; const LAS float* lr2 = lr + (16 * 81 + 16);
            const float rstd = 1.0f / sqrtf((lg[16 * 81 + lane] + lg[(16 * 81 + 16) + 16 * 81 + lane]) * (1.0f / DM) + EPS);
            float best = -3.0e38f; int gsel = 0; float glv[8];
#pragma unroll
            for (int j = 0; j < 8; ++j) { glv[j] = (lr[j] + lr2[j]) * rstd + F.rgb[j]; if (glv[j] > best) { best = glv[j]; gsel = j; } }
            float sum = 0.f;
#pragma unroll
            for (int j = 0; j < 8; ++j) sum += expf(glv[j] - best);
            const float gp = 1.0f / sum;
            float b1 = -3.0e38f, b2 = -3.0e38f; int i1 = 0, i2 = 0;
#pragma unroll
            for (int j = 0; j < 8; ++j) { const float v = (lr[8 + gsel * 8 + j] + lr2[8 + gsel * 8 + j]) * rstd + F.reb[gsel * 8 + j];
                if (v > b1) { b2 = b1; i2 = i1; b1 = v; i1 = j; } else if (v > b2) { b2 = v; i2 = j; } }
            const float e2 = expf(b2 - b1); const float w1 = gp / (1.0f + e2), w2 = gp * e2 / (1.0f + e2);
            F.RSTD2[token] = rstd;
            const int ex1 = gsel * 8 + i1, ex2 = gsel * 8 + i2;
            const unsigned p1 = atomicAdd(F.ctl + CW_CNT + 64 * ex1, 1u); F.LIST[ex1 * LISTCAP + p1] = token * 2; F.AW[token * 2] = w1; F.APOS[token * 2] = (ex1 << 16) | (int)p1;
            const unsigned p2 = atomicAdd(F.ctl + CW_CNT + 64 * ex2, 1u); F.LIST[ex2 * LISTCAP + p2] = token * 2 + 1; F.AW[token * 2 + 1] = w2; F.APOS[token * 2 + 1] = (ex2 << 16) | (int)p2;
        }
        __syncthreads();
    }
}

__device__ __forceinline__ void phase_final(Frame& F) {
    const int gw = F.vcu * 8 + F.wave, NGW = F.G * 8;
    const LAS int* tstart = (const LAS int*)(F.lds + TAB_OFF) + 64;
    u32x2 xa[16], pa[16], qa[16], xb[16], pb[16], qb[16]; float w0a, w1a, w0b, w1b;
#define FIN_LOAD(m, X, P, Q, W0, W1) do { const int ap0_ = F.APOS[2 * (m)], ap1_ = F.APOS[2 * (m) + 1]; W0 = F.AW[2 * (m)]; W1 = F.AW[2 * (m) + 1]; \
        const int row0_ = tstart[ap0_ >> 16] * 256 + (ap0_ & 0xffff), row1_ = tstart[ap1_ >> 16] * 256 + (ap1_ & 0xffff); \
        const u32x2* xr_ = (const u32x2*)(F.X1 + (size_t)(m) * DM) + F.lane; const u32x2* y0_ = (const u32x2*)(F.YT + (size_t)row0_ * DM) + F.lane; const u32x2* y1_ = (const u32x2*)(F.YT + (size_t)row1_ * DM) + F.lane; \
        _Pragma("unroll") for (int j = 0; j < 16; ++j) { X[j] = __builtin_nontemporal_load(xr_ + 64 * j); P[j] = __builtin_nontemporal_load(y0_ + 64 * j); Q[j] = __builtin_nontemporal_load(y1_ + 64 * j); } } while (0)
    int m = gw;
    if (m < NTOK) FIN_LOAD(m, xa, pa, qa, w0a, w1a);
    for (; m < NTOK; m += NGW) {
        const bool has = (m + NGW) < NTOK;
        if (has) FIN_LOAD(m + NGW, xb, pb, qb, w0b, w1b);
        f32x4* orow = (f32x4*)(F.out + (size_t)m * DM) + F.lane; const f32x4* gr = (const f32x4*)F.gf + F.lane;
        f32x4 v[16]; float ss = 0.f;
#pragma unroll
        for (int j = 0; j < 16; ++j) { const f32x4 a = (f32x4){bf_lo(xa[j].x), bf_hi(xa[j].x), bf_lo(xa[j].y), bf_hi(xa[j].y)};
            v[j].x = a.x + w0a * bf_lo(pa[j].x) + w1a * bf_lo(qa[j].x); v[j].y = a.y + w0a * bf_hi(pa[j].x) + w1a * bf_hi(qa[j].x); v[j].z = a.z + w0a * bf_lo(pa[j].y) + w1a * bf_lo(qa[j].y); v[j].w = a.w + w0a * bf_hi(pa[j].y) + w1a * bf_hi(qa[j].y);
            ss += (v[j].x * v[j].x + v[j].y * v[j].y) + (v[j].z * v[j].z + v[j].w * v[j].w); }
        ss = wave_sum(ss);
        const float rstd = 1.0f / sqrtf(ss * (1.0f / DM) + EPS);
#pragma unroll
        for (int j = 0; j < 16; ++j) __builtin_nontemporal_store(v[j] * rstd * gr[64 * j], orow + 64 * j);
        if (has) { w0a = w0b; w1a = w1b;
#pragma unroll
            for (int j = 0; j < 16; ++j) { xa[j] = xb[j]; pa[j] = pb[j]; qa[j] = qb[j]; } }
    }
#undef FIN_LOAD
}

__device__ __forceinline__ int moe_tables(Frame& F) {
    LAS int* cnts = (LAS int*)(F.lds + TAB_OFF); LAS int* tstart = cnts + 64; LAS int* tl = cnts + 144;
    __syncthreads();
    if (F.tid < 64) {
        const int e = F.tid, cnt = (int)F.ctl[CW_CNT + 64 * e]; cnts[e] = cnt;
        const int nt = (cnt + 255) >> 8, nsmall = (nt > 0 && cnt - 256 * (nt - 1) <= 128) ? 1 : 0, nbig = nt - nsmall;
        int pt = nt, pb = nbig, ps = nsmall;
#pragma unroll
        for (int o = 1; o < 64; o <<= 1) { const int a = __shfl_up(pt, o), b = __shfl_up(pb, o), c = __shfl_up(ps, o); if (e >= o) { pt += a; pb += b; ps += c; } }
        const int Tb = __shfl(pb, 63), T = __shfl(pt, 63);
        tstart[e] = pt - nt; if (e == 63) { tstart[64] = T; cnts[130] = Tb; }
        for (int t = 0; t < nbig; ++t) tl[pb - nbig + t] = (e << 8) | t;
        if (nsmall) tl[Tb + ps - 1] = (e << 8) | (nt - 1);
    }
    __syncthreads();
    return tstart[64];
}
__device__ __forceinline__ const float* in_ptr(LAS unsigned char* lds, int k) {
    const unsigned long long v = ((const LAS unsigned long long*)(lds + PTAB_OFF))[k];
    const unsigned lo = __builtin_amdgcn_readfirstlane((unsigned)v), hi = __builtin_amdgcn_readfirstlane((unsigned)(v >> 32));
    return (const float*)(const GAS float*)(((unsigned long long)hi << 32) | lo);
}
constexpr int N_PHASES = 10;
struct Args { const float* in[19]; float* out; unsigned char* ws; int ph_lo, ph_hi, li, pad; };
__global__ void __launch_bounds__(512, 2) fwd_kernel(Args args) {
    extern __shared__ __attribute__((aligned(16))) unsigned char lds_raw[];
    Frame F;
    F.lds = (LAS unsigned char*)lds_raw;
    volatile LAS unsigned* MISC = (volatile LAS unsigned*)(F.lds + MISC_OFF);
    F.tid = threadIdx.x; F.lane = F.tid & 63; F.wave = __builtin_amdgcn_readfirstlane(F.tid >> 6);
    F.G = gridDim.x; { const int bx = blockIdx.x; F.vcu = (F.G % 8 == 0) ? (bx % 8) * (F.G / 8) + bx / 8 : bx; }
    unsigned char* ws = args.ws;
    F.ctl = (unsigned*)(ws + WS_CTL);
    F.out = args.out;
    for (int u = F.tid; u < 128; u += 512) ((LAS unsigned*)(F.lds + MISC_OFF))[u] = 0u;
    __syncthreads();
    if (F.tid == 0) { LAS unsigned long long* pt = (LAS unsigned long long*)(F.lds + PTAB_OFF);
#pragma unroll
        for (int k = 0; k < 19; ++k) pt[k] = (unsigned long long)args.in[k]; }
    __syncthreads();
#define INP(k) in_ptr(F.lds, (k))
#define WSP(T, off) ((T*)(ws + (off)))
    XcdBarrier bar; bar.bar = F.ctl + CW_BAR; bar.x = 0; bar.st = nullptr;
    if (MK_N_LAUNCHES == 1) bar = xcd_barrier_post(F.ctl + CW_BAR, MISC + 8);
    const int lo = args.ph_lo, hi = args.ph_hi;
#ifndef PHASE_MASK
#define PHASE_MASK 0x3ff
#endif
#define IN(k) ((((PHASE_MASK) >> (k)) & 1) && lo <= (k) && (k) < hi)
#define RELANE() do { int l_ = (int)__builtin_amdgcn_mbcnt_hi(~0u, __builtin_amdgcn_mbcnt_lo(~0u, 0u)); asm volatile("" : "+v"(l_)); F.lane = l_; F.tid = F.wave * 64 + F.lane; } while (0)
#define SEAM(k) do { if (IN(k) && IN((k) + 1)) xcd_barrier(bar, F.wave == 0 && __builtin_amdgcn_mbcnt_hi(~0u, __builtin_amdgcn_mbcnt_lo(~0u, 0u)) == 0u); } while (0)
#ifndef REPS_MASK
#define REPS_MASK 0
#endif
#define NREP(k) ((((REPS_MASK) >> (k)) & 1) ? 2 : 1)

    if (IN(0)) { RELANE(); F.g2 = INP(10); F.x = INP(0); F.g1 = INP(1); F.w_in = INP(2); F.w_out = INP(9); F.rgw = INP(11); F.rew = INP(13); F.wg = INP(15); F.wu = INP(16); F.wd = INP(17);
        F.ACT = WSP(bf16_t, WS_ACT); F.GATES = WSP(float, WS_GATES); F.WIN_T = WSP(bf16_t, WS_WIN); F.WOUT_T = WSP(bf16_t, WS_WOUT); F.WGU_T = WSP(bf16_t, WS_WGU); F.WD_T = WSP(bf16_t, WS_WD); F.WRT = WSP(bf16_t, WS_WRT);
        F.GT = WSP(float, WS_GT); phase0_gt(F);
        if (MK_N_LAUNCHES == 1) xcd_barrier(bar, F.wave == 0 && __builtin_amdgcn_mbcnt_hi(~0u, __builtin_amdgcn_mbcnt_lo(~0u, 0u)) == 0u);
        RELANE();
        for (int rep = 0; rep < NREP(0); ++rep) { phase0(F); RELANE(); phase0b(F); __syncthreads(); } } SEAM(0);
    if (IN(1)) { RELANE();
        if ((int)blockIdx.x < 16) { F.igb = INP(6); F.fgb = INP(7); F.GATES = WSP(float, WS_GATES); F.GS = WSP(float, WS_GS); for (int bh = (int)blockIdx.x; bh < 16; bh += F.G) phase_gates(F, bh); RELANE(); }
        if ((int)blockIdx.x < NCONV && F.G > 2 * NCONV) {
            F.g2 = INP(10); F.wg = INP(15); F.wu = INP(16); F.wd = INP(17); F.WGU_T = WSP(bf16_t, WS_WGU); F.WD_T = WSP(bf16_t, WS_WD); F.w_in = INP(2); F.w_out = INP(9); F.WIN_T = WSP(bf16_t, WS_WIN); F.WOUT_T = WSP(bf16_t, WS_WOUT);
            phase_convert(F, ITEMS_DENSE, NITEMS, (int)blockIdx.x * 8 + F.wave, -(NCONV * 8)); __syncthreads();
        } else if (F.G <= 2 * NCONV) {
            F.g2 = INP(10); F.wg = INP(15); F.wu = INP(16); F.wd = INP(17); F.WGU_T = WSP(bf16_t, WS_WGU); F.WD_T = WSP(bf16_t, WS_WD); F.w_in = INP(2); F.w_out = INP(9); F.WIN_T = WSP(bf16_t, WS_WIN); F.WOUT_T = WSP(bf16_t, WS_WOUT);
            phase_convert(F, ITEMS_DENSE, NITEMS, F.vcu * 8 + F.wave, F.G * 8); __syncthreads(); }
        { pg8::DynSched<4096> S; S.init(NTOK, NPROJ, WSP(bf16_t, WS_ACT), WSP(bf16_t, WS_WIN), F.ctl + CW_Q1, (volatile LAS int*)(F.lds + TAB_OFF), (int)xb_xcc_id()); S.t0 = (F.tid == 0); S.prime();
          pg8::EpiProj E{WSP(bf16_t, WS_PROJ), WSP(bf16_t, WS_QH), WSP(bf16_t, WS_KH), WSP(bf16_t, WS_VH), WSP(float, WS_VSSP)};
          pg8::gemm_phase<pg8::EpiProj, pg8::DynSched<4096>, 4096>(F.lds, S, E, F.wave, F.lane); }
        } SEAM(1);
    if (IN(2)) { RELANE(); F.gvn = INP(3); F.gsw = INP(4); F.gsb = INP(5); F.igb = INP(6); F.fgb = INP(7);
        F.PROJ = WSP(bf16_t, WS_PROJ); F.ACT = WSP(bf16_t, WS_ACT); F.GATES = WSP(float, WS_GATES); F.HB = WSP(float, WS_HB); F.QH = WSP(bf16_t, WS_QH); F.KH = WSP(bf16_t, WS_KH); F.VH = WSP(bf16_t, WS_VH); F.VSSP = WSP(float, WS_VSSP); F.GS = WSP(float, WS_GS);
#ifndef P2_SEL
#define P2_SEL 3
#endif
        F.PM = WSP(bf16_t, WS_PM); F.KP = WSP(bf16_t, WS_KP); phase_mlstm_pre(F);
        if (MK_N_LAUNCHES == 1) xcd_barrier(bar, F.wave == 0 && __builtin_amdgcn_mbcnt_hi(~0u, __builtin_amdgcn_mbcnt_lo(~0u, 0u)) == 0u);
        RELANE();
        for (int rep = 0; rep < NREP(9); ++rep) phase_mlstm(F); RELANE(); for (int rep = 0; rep < NREP(10); ++rep) phase_gmlp(F); } SEAM(2);
    if (IN(3)) { RELANE(); F.ogn = INP(8); F.PROJ = WSP(bf16_t, WS_PROJ); F.ACT = WSP(bf16_t, WS_ACT); F.HB = WSP(float, WS_HB); for (int rep = 0; rep < NREP(3); ++rep) phase_mlnorm(F); } SEAM(3);
    if (IN(4)) { RELANE(); pg8::DenseSched<4096> S; S.init(NTOK, DM, F.G, (int)blockIdx.x, WSP(bf16_t, WS_ACT), WSP(bf16_t, WS_WOUT)); pg8::EpiRes E{INP(0), WSP(bf16_t, WS_X1)};
        pg8::gemm_phase<pg8::EpiRes, pg8::DenseSched<4096>, 4096>(F.lds, S, E, F.wave, F.lane);
        if (NREP(4) == 2) { __syncthreads(); pg8::gemm_phase<pg8::EpiRes, pg8::DenseSched<4096>, 4096>(F.lds, S, E, F.wave, F.lane); } } SEAM(4);
    if (IN(5)) { RELANE(); F.g2 = INP(10); F.rgb = INP(12); F.reb = INP(14); F.ACT = WSP(bf16_t, WS_ACT); F.WRT = WSP(bf16_t, WS_WRT); F.RSTD2 = WSP(float, WS_RSTD2); F.AW = WSP(float, WS_AW); F.LIST = WSP(int, WS_LIST); F.APOS = WSP(int, WS_APOS); F.X1 = WSP(bf16_t, WS_X1);
        phase_router(F); } SEAM(5);
#define MOE_SCHED_INIT(S) do { S.cnts = (const LAS int*)(F.lds + TAB_OFF); S.tstart = S.cnts + 64; S.tl = S.cnts + 144; S.G = F.G; S.c = F.vcu; S.list = WSP(int, WS_LIST); S.ctr = nullptr; S.slot = nullptr; S.t0 = false; } while (0)
#define MOE_GU(S) do { S.A = (const char*)WSP(bf16_t, WS_X1); S.Bt = (const char*)WSP(bf16_t, WS_WGU); S.bexp = (size_t)1024 * DM * 2; } while (0)
#define MOE_DN(S) do { S.A = (const char*)WSP(bf16_t, WS_HM); S.Bt = (const char*)WSP(bf16_t, WS_WD); S.bexp = (size_t)DM * DEXP * 2; } while (0)
    if (IN(6)) { RELANE(); const int T = moe_tables(F); const int U6 = (T * 4 < ((2 * F.G) & ~3)) ? T * 4 : ((2 * F.G) & ~3);
        pg8::MoeSched<4096, 2, true> S; MOE_SCHED_INIT(S); MOE_GU(S); S.u_lo = 0; S.u_hi = U6;
        pg8::EpiGU E{WSP(bf16_t, WS_HM), WSP(int, WS_LIST), WSP(float, WS_RSTD2)};
        pg8::gemm_phase<pg8::EpiGU, pg8::MoeSched<4096, 2, true>, 4096, true>(F.lds, S, E, F.wave, F.lane); } SEAM(6);
    if (IN(7)) { RELANE(); const int T = ((const LAS int*)(F.lds + TAB_OFF))[128];     const int U6 = (T * 4 < ((2 * F.G) & ~3)) ? T * 4 : ((2 * F.G) & ~3); const int T6 = U6 >> 2;
        { pg8::MoeSched<4096, 2, true, true> S; MOE_SCHED_INIT(S); MOE_GU(S); S.u_lo = U6; S.u_hi = T * 4; S.ctr = F.ctl + CW_QA; S.slot = (volatile LAS int*)(F.lds + TAB_OFF + 1408); S.t0 = (F.tid == 0); S.prime();
          pg8::EpiGU E{WSP(bf16_t, WS_HM), WSP(int, WS_LIST), WSP(float, WS_RSTD2)};
          pg8::gemm_phase<pg8::EpiGU, pg8::MoeSched<4096, 2, true, true>, 4096, true>(F.lds, S, E, F.wave, F.lane); }
        __syncthreads(); RELANE();
        { pg8::MoeSched<512, 4, false, true> S; MOE_SCHED_INIT(S); MOE_DN(S); S.u_lo = 0; S.u_hi = T6 * 16; S.ctr = F.ctl + CW_QB; S.slot = (volatile LAS int*)(F.lds + TAB_OFF + 1440); S.t0 = (F.tid == 0); S.prime();
          pg8::EpiDown E{WSP(bf16_t, WS_YT)};
          pg8::gemm_phase<pg8::EpiDown, pg8::MoeSched<512, 4, false, true>, 512, true>(F.lds, S, E, F.wave, F.lane); } } SEAM(7);
    if (IN(8)) { RELANE(); const int T = ((const LAS int*)(F.lds + TAB_OFF))[128]; const int U6 = (T * 4 < ((2 * F.G) & ~3)) ? T * 4 : ((2 * F.G) & ~3); const int T6 = U6 >> 2;
        pg8::MoeSched<512, 4, false> S; MOE_SCHED_INIT(S); MOE_DN(S); S.u_lo = T6 * 16; S.u_hi = T * 16;
        pg8::EpiDown E{WSP(bf16_t, WS_YT)};
        pg8::gemm_phase<pg8::EpiDown, pg8::MoeSched<512, 4, false>, 512, true>(F.lds, S, E, F.wave, F.lane); } SEAM(8);
    if (IN(9)) { RELANE(); F.gf = INP(18); F.YT = WSP(bf16_t, WS_YT); F.AW = WSP(float, WS_AW); F.APOS = WSP(int, WS_APOS); F.X1 = WSP(bf16_t, WS_X1);
        phase_final(F); }
#undef IN
#undef SEAM
}

extern "C" void kernel_launch(void* const* d_in, const int* in_sizes, int n_in, void* d_out, int out_size, void* d_ws, size_t ws_size, hipStream_t stream) {
    static int grid = 0;
    if (grid == 0) {
        if (n_in != 19 || out_size != NTOK * DM || ws_size < WS_END) { fprintf(stderr, "kernel_launch: unexpected shapes (n_in %d, out %d, ws %zu)\n", n_in, out_size, ws_size); grid = -1; return; }
        int dev = 0, cus = 0, per_cu = 0;
        if (hipGetDevice(&dev) != hipSuccess || hipDeviceGetAttribute(&cus, hipDeviceAttributeMultiprocessorCount, dev) != hipSuccess) { grid = -1; return; }
        if (hipFuncSetAttribute((const void*)fwd_kernel, hipFuncAttributeMaxDynamicSharedMemorySize, LDS_BYTES) != hipSuccess) { fprintf(stderr, "kernel_launch: hipFuncSetAttribute failed\n"); grid = -1; return; }
        if (hipOccupancyMaxActiveBlocksPerMultiprocessor(&per_cu, (const void*)fwd_kernel, 512, LDS_BYTES) != hipSuccess || per_cu < 1) fprintf(stderr, "kernel_launch: occupancy query reports %d\n", per_cu);
        (void)hipGetLastError();
        grid = cus;
    }
    if (grid < 0) return;
    if (hipMemsetAsync((char*)d_ws + WS_CTL, 0, CTL_ZERO_BYTES, stream) != hipSuccess) return;
    Args a{};
    for (int i = 0; i < 19; ++i) a.in[i] = (const float*)d_in[i];
    a.out = (float*)d_out; a.ws = (unsigned char*)d_ws; a.pad = 0;
    if (MK_N_LAUNCHES == 1) { a.ph_lo = 0; a.ph_hi = N_PHASES; a.li = 0; hipLaunchKernelGGL(fwd_kernel, dim3(grid), dim3(512), LDS_BYTES, stream, a); }
    else for (int li = 0; li < N_PHASES; ++li) { a.ph_lo = li; a.ph_hi = li + 1; a.li = li; hipLaunchKernelGGL(fwd_kernel, dim3(grid), dim3(512), LDS_BYTES, stream, a); }
}
```

```cpp
#include <hip/hip_runtime.h>
#include <cstdio>
#include <cstdint>

#ifndef MK_N_LAUNCHES
#define MK_N_LAUNCHES 1
#endif

#define LAS __attribute__((address_space(3)))
#define GAS __attribute__((address_space(1)))
typedef unsigned short bf16_t;
typedef short bf16x8 __attribute__((ext_vector_type(8)));
typedef float f32x4 __attribute__((ext_vector_type(4)));
typedef float f32x2 __attribute__((ext_vector_type(2)));
typedef unsigned u32x4 __attribute__((ext_vector_type(4)));
typedef unsigned u32x2 __attribute__((ext_vector_type(2)));

constexpr int DM = 4096, NTOK = 16384, SEQL = 4096;
constexpr int NPROJ = 10240, LDW_IN = 10248;
constexpr int C_U = 0, C_V = 2048, C_Q = 4096, C_K = 5120, C_VB = 6144, C_O = 8192;
constexpr int NEXP = 64, DEXP = 512, LISTCAP = 16384;
constexpr float EPS = 1e-6f;

constexpr size_t MiB = 1u << 20;
constexpr size_t WS_CTL = 0, CTL_ZERO_BYTES = 1 * MiB;
constexpr size_t WS_GATES = 1 * MiB;
constexpr size_t WS_RSTD2 = 1 * MiB + 512 * 1024;
constexpr size_t WS_AW = WS_RSTD2 + 64 * 1024;
constexpr size_t WS_APOS = WS_AW + 128 * 1024;
constexpr size_t WS_WRT = 2 * MiB;
constexpr size_t WS_LIST = 3 * MiB;
constexpr size_t WS_GS = 7 * MiB;
constexpr size_t WS_WIN = 8 * MiB;
constexpr size_t WS_WOUT = 88 * MiB;
constexpr size_t WS_WGU = 120 * MiB;
constexpr size_t WS_WD = 632 * MiB;
constexpr size_t WS_ACT = 888 * MiB;
constexpr size_t WS_PROJ = 1016 * MiB;
constexpr size_t WS_YT = WS_PROJ;
constexpr size_t WS_HM = 1464 * MiB;
constexpr size_t WS_PM = WS_HM;
constexpr size_t WS_KP = WS_HM + 16 * MiB;
constexpr size_t WS_HB = 1336 * MiB;
constexpr size_t WS_QH = 1512 * MiB;
constexpr size_t WS_KH = 1544 * MiB;
constexpr size_t WS_VH = 1576 * MiB;
constexpr size_t WS_X1 = 1640 * MiB;
constexpr size_t WS_VSSP = 1768 * MiB;
constexpr size_t WS_END = 1770 * MiB;
constexpr int CW_BAR = 4096;
constexpr int CW_CNT = 16384;
constexpr int CW_QA = 26624, CW_QB = 26688;
constexpr int CW_Q1 = 24576;

constexpr int LDS_BYTES = 147456;
constexpr int TAB_OFF = 131072;
constexpr int MISC_OFF = LDS_BYTES - 512;
constexpr int PTAB_OFF = MISC_OFF + 256;

__device__ __forceinline__ unsigned f2bf(float f) { unsigned u = __builtin_bit_cast(unsigned, f); return (u + 0x7fffu + ((u >> 16) & 1u)) >> 16; }
__device__ __forceinline__ float bf2f(unsigned b) { return __builtin_bit_cast(float, b << 16); }
__device__ __forceinline__ unsigned pk2(float lo, float hi) { return f2bf(lo) | (f2bf(hi) << 16); }
__device__ __forceinline__ float bf_lo(unsigned w) { return __builtin_bit_cast(float, w << 16); }
__device__ __forceinline__ float bf_hi(unsigned w) { return __builtin_bit_cast(float, w & 0xffff0000u); }
__device__ __forceinline__ float wave_sum(float v) {
#pragma unroll
    for (int o = 1; o < 64; o <<= 1) v += __shfl_xor(v, o);
    return v;
}
__device__ __forceinline__ float fast_exp(float x) { return __builtin_amdgcn_exp2f(x * 1.4426950408889634f); }
__device__ __forceinline__ float gelu_tanh(float x) {
    const float t = x * (1.0f + 0.044715f * x * x) * 1.5957691216057308f;
    return x * __builtin_amdgcn_rcpf(1.0f + fast_exp(-t));
}
__device__ __forceinline__ float sigmoid_f(float x) { return __builtin_amdgcn_rcpf(1.0f + fast_exp(-x)); }
__device__ __forceinline__ unsigned cvtpk(float lo, float hi) { unsigned r; asm volatile("v_cvt_pk_bf16_f32 %0, %1, %2" : "=v"(r) : "v"(lo), "v"(hi)); return r; }
#define LDS_WAIT() asm volatile("s_waitcnt lgkmcnt(0)" ::: "memory")
#define VM_WAIT() asm volatile("s_waitcnt vmcnt(0)" ::: "memory")
#define LDS_BARRIER() do { asm volatile("s_waitcnt lgkmcnt(0)" ::: "memory"); __builtin_amdgcn_s_barrier(); asm volatile("" ::: "memory"); } while (0)
__device__ __forceinline__ f32x4 mfma16(bf16x8 a, bf16x8 b, f32x4 c) { return __builtin_amdgcn_mfma_f32_16x16x32_bf16(a, b, c, 0, 0, 0); }

namespace pg8 {
constexpr int BM = 256, BK = 64, HALF = 128, HTB = HALF * BK * 2, STAGE_BYTES = 8 * HTB, NXCD = 8, WGM = 8;
__host__ __device__ __forceinline__ int lds_byte(int r, int c) { const int st = (r >> 4) * 2 + (c >> 5), rr = r & 15, cc = c & 31, ob = rr * 64 + cc * 2; return st * 1024 + (ob ^ (((ob >> 9) & 1) << 5)); }
__host__ __device__ __forceinline__ void stage_rc(int b, int& R, int& C) { const int st = b / 1024, sb = b % 1024, swz = sb ^ (((sb >> 9) & 1) << 5); R = (st >> 1) * 16 + swz / 64; C = (st & 1) * 32 + (swz % 64) / 2; }
__host__ __device__ __forceinline__ int perm32(int rho) { const int n = rho >> 4, i = rho & 15; return 8 * (i >> 2) + 4 * n + (i & 3); }

struct Unit { int pm, pn, e, nvalid, rowbase; };

template <int K> struct DenseSched {
    int nM, nN, nwg, G, c; const char* A; const char* Bt;
    __device__ void init(int M, int N, int G_, int c_, const void* A_, const void* Bt_) { nM = M / BM; nN = N / BM; nwg = nM * nN; G = G_; c = c_; A = (const char*)A_; Bt = (const char*)Bt_; }
    __device__ __forceinline__ bool next(int i, Unit& u) const {
        const long L = (long)i * G + c; if (L >= nwg) return false;
        int wgid = (int)L; { const int q = nwg / NXCD, r = nwg % NXCD, xcd = wgid % NXCD, off = wgid / NXCD; wgid = (xcd < r ? xcd * (q + 1) : r * (q + 1) + (xcd - r) * q) + off; }
        const int nig = WGM * nN, gid = wgid / nig, fm = gid * WGM, gsz = (nM - fm) < WGM ? (nM - fm) : WGM;
        u.pm = fm + ((wgid % nig) % gsz); u.pn = (wgid % nig) / gsz; u.e = 0; u.nvalid = 256; u.rowbase = u.pm * 256; return true;
    }
    __device__ __forceinline__ const char* a_base() const { return A; }
    __device__ __forceinline__ unsigned a_off(const Unit& u, int row) const { return (unsigned)(u.pm * 256 + row) * (unsigned)(K * 2); }
    __device__ __forceinline__ const char* b_ptr(const Unit& u) const { return Bt + (size_t)u.pn * 256 * K * 2; }
};
template <int K> struct DynSched {
    int nM, nN, nwg, xcc; const char* A; const char* Bt; unsigned* ctr; volatile LAS int* slot; bool t0;
    __device__ void init(int M, int N, const void* A_, const void* Bt_, unsigned* ctr_, volatile LAS int* slot_, int xcc_) { nM = M / BM; nN = N / BM; nwg = nM * nN; A = (const char*)A_; Bt = (const char*)Bt_; ctr = ctr_; slot = slot_; xcc = xcc_ & 7; }
    __device__ __forceinline__ int draw() const {
        const int per = nwg / NXCD;
        for (int a = 0; a < NXCD; ++a) { const int x = (xcc + a) & 7; const int n = (int)__hip_atomic_fetch_add(ctr + 64 * x, 1u, __ATOMIC_RELAXED, __HIP_MEMORY_SCOPE_AGENT); if (n < per) return NXCD * n + x; }
        return nwg;
    }
    __device__ __forceinline__ void prime() const {
        if (t0) { slot[0] = draw(); slot[1] = draw(); }
        __syncthreads();
    }
    __device__ __forceinline__ bool next(int i, Unit& u) const {
        const int L = __builtin_amdgcn_readfirstlane(slot[i & 3]);
        if (i >= 1 && t0) slot[(i + 1) & 3] = (L < nwg) ? draw() : nwg;
        if (L >= nwg) return false;
        int wgid = L; { const int q = nwg / NXCD, r = nwg % NXCD, xcd = wgid % NXCD, off = wgid / NXCD; wgid = (xcd < r ? xcd * (q + 1) : r * (q + 1) + (xcd - r) * q) + off; }
        const int nig = WGM * nN, gid = wgid / nig, fm = gid * WGM, gsz = (nM - fm) < WGM ? (nM - fm) : WGM;
        u.pm = fm + ((wgid % nig) % gsz); u.pn = (wgid % nig) / gsz; u.e = 0; u.nvalid = 256; u.rowbase = u.pm * 256; return true;
    }
    __device__ __forceinline__ const char* a_base() const { return A; }
    __device__ __forceinline__ unsigned a_off(const Unit& u, int row) const { return (unsigned)(u.pm * 256 + row) * (unsigned)(K * 2); }
    __device__ __forceinline__ const char* b_ptr(const Unit& u) const { return Bt + (size_t)u.pn * 256 * K * 2; }
};
template <int K, int NPN_SHIFT, bool GATHER, bool DYN = false> struct MoeSched {
    const LAS int* cnts; const LAS int* tstart; const LAS int* tl; int u_lo, u_hi, G, c; const int* list; const char* A; const char* Bt; size_t bexp;
    unsigned* ctr; volatile LAS int* slot; bool t0;
    __device__ __forceinline__ int draw() const { return (int)__hip_atomic_fetch_add(ctr, 1u, __ATOMIC_RELAXED, __HIP_MEMORY_SCOPE_AGENT); }
    __device__ __forceinline__ void prime() const { if (t0) { slot[0] = draw(); slot[1] = draw(); } __syncthreads(); }
    __device__ __forceinline__ bool next(int i, Unit& u) const {
        int L;
        if (DYN) { const int n = __builtin_amdgcn_readfirstlane(slot[i & 3]); const int cntu = u_hi - u_lo;
            if (i >= 1 && t0) slot[(i + 1) & 3] = (n < cntu) ? draw() : cntu;
            if (n >= cntu) return false; L = u_lo + n; }
        else { L = u_lo + i * G + c; if (L >= u_hi) return false; }
        const int pk = __builtin_amdgcn_readfirstlane(tl[L >> NPN_SHIFT]); const int e = pk >> 8;
        u.pn = L & ((1 << NPN_SHIFT) - 1); u.e = e; u.pm = pk & 255;
        int nv = cnts[e] - u.pm * 256; nv = nv > 256 ? 256 : nv; u.nvalid = __builtin_amdgcn_readfirstlane(nv); u.rowbase = __builtin_amdgcn_readfirstlane((tstart[e] + u.pm) * 256); return true;
    }
    __device__ __forceinline__ const char* a_base() const { return A; }
    __device__ __forceinline__ unsigned a_off(const Unit& u, int row) const {
        if (GATHER) { int tok = 0; if (row < u.nvalid) tok = list[u.e * LISTCAP + u.pm * 256 + row] >> 1; return (unsigned)tok * (unsigned)(K * 2); }
        else return (unsigned)(u.rowbase + row) * (unsigned)(K * 2);
    }
    __device__ __forceinline__ const char* b_ptr(const Unit& u) const { return Bt + (size_t)u.e * bexp + (size_t)u.pn * 256 * K * 2; }
};

__device__ __forceinline__ unsigned cvt_pk_bf16(float lo, float hi) { unsigned r; asm volatile("v_cvt_pk_bf16_f32 %0, %1, %2" : "=v"(r) : "v"(lo), "v"(hi)); return r; }

template <class Epi, class Sched, int K, bool SKIP = false>
__device__ __forceinline__ void gemm_phase(LAS unsigned char* lds, const Sched& S, const Epi& E, const int wid, const int lane) {
    const int tid = wid * 64 + lane, wr = wid >> 2, wc = wid & 3, fr = lane & 15, fq = lane >> 4;
    constexpr int nt = K / BK;
    unsigned voffB[2]; int RA[2]; unsigned CA2[2];
#pragma unroll
    for (int i = 0; i < 2; ++i) { int R, C; stage_rc(tid * 16 + i * 8192, R, C); const int Rb = Epi::PERM ? ((R & ~31) + perm32(R & 31)) : R;
        RA[i] = R; CA2[i] = (unsigned)C * 2u; voffB[i] = (unsigned)(Rb * K + C) * 2u; }
    constexpr size_t kstep = (size_t)(BK * 2);
    constexpr size_t hstep = (size_t)HALF * K * 2;
    const unsigned ldsw = (unsigned)wid * 1024u;
    const int aoffl = lds_byte(wr * 64 + fr, fq * 8), boffl = lds_byte(wc * 32 + fr, fq * 8);
#define PG8_SA(b, h) (((b) * 2 + (h)) * HTB)
#define PG8_SB(b, h) ((4 + (b) * 2 + (h)) * HTB)
#define PG8_STAGE(bufoff, gbase, voff) do { _Pragma("unroll") for (int _i = 0; _i < 2; ++_i) \
        __builtin_amdgcn_global_load_lds((const unsigned*)((const char*)(gbase) + (voff)[_i]), (LAS unsigned*)(lds + (bufoff) + ldsw + _i * 8192), 16, 0, 0); } while (0)
#define PG8_LDA(dst, b, h) do { _Pragma("unroll") for (int m = 0; m < 4; ++m) _Pragma("unroll") for (int k = 0; k < 2; ++k) dst[m][k] = *(const LAS bf16x8*)(lds + PG8_SA(b, h) + aoffl + m * 2048 + k * 1024); } while (0)
#define PG8_LDB(dst, b, h) do { _Pragma("unroll") for (int n = 0; n < 2; ++n) _Pragma("unroll") for (int k = 0; k < 2; ++k) dst[n][k] = *(const LAS bf16x8*)(lds + PG8_SB(b, h) + boffl + n * 2048 + k * 1024); } while (0)
#define PG8_MMA(ai, bj, At, Bt) do { if (SKIP && !((ai) ? doA1 : doA0)) break; __builtin_amdgcn_s_setprio(1); _Pragma("unroll") for (int m = 0; m < 4; ++m) _Pragma("unroll") for (int n = 0; n < 2; ++n) _Pragma("unroll") for (int k = 0; k < 2; ++k) \
        acc[ai][bj][m][n] = __builtin_amdgcn_mfma_f32_16x16x32_bf16(Bt[n][k], At[m][k], acc[ai][bj][m][n], 0, 0, 0); __builtin_amdgcn_s_setprio(0); } while (0)
#define PG8_WAIT_V(n) asm volatile("s_waitcnt vmcnt(" #n ")" ::: "memory")
#define PG8_WAIT_L(n) asm volatile("s_waitcnt lgkmcnt(" #n ")" ::: "memory")
#define PG8_BAR __builtin_amdgcn_s_barrier()
#define PG8_SCHED __builtin_amdgcn_sched_barrier(0)
#define PG8_LOAD_AOFF(u) do { _Pragma("unroll") for (int _h = 0; _h < 2; ++_h) _Pragma("unroll") for (int _i = 0; _i < 2; ++_i) aoff[_h][_i] = S.a_off(u, _h * HALF + RA[_i]) + CA2[_i]; } while (0)
    Unit cur, nxt; int ui = 0;
    if (!S.next(0, cur)) return;
    f32x4 acc[2][2][4][2];
#pragma unroll
    for (int a = 0; a < 2; ++a)
#pragma unroll
        for (int b = 0; b < 2; ++b)
#pragma unroll
            for (int m = 0; m < 4; ++m)
#pragma unroll
                for (int n = 0; n < 2; ++n) acc[a][b][m][n] = (f32x4){0.f, 0.f, 0.f, 0.f};
    bf16x8 At[4][2], B0[2][2], B1[2][2];
    unsigned aoff[2][2];
    const char* const Ab = S.a_base();
    const char* cB = S.b_ptr(cur);
    PG8_LOAD_AOFF(cur);
    PG8_STAGE(PG8_SB(0, 0), cB, voffB); PG8_STAGE(PG8_SB(0, 1), cB + hstep, voffB); PG8_STAGE(PG8_SA(0, 0), Ab, aoff[0]); PG8_STAGE(PG8_SA(0, 1), Ab, aoff[1]);
    if (wr == 1) PG8_BAR;
    PG8_WAIT_V(2); PG8_BAR;
    PG8_STAGE(PG8_SB(1, 0), cB + kstep, voffB); PG8_STAGE(PG8_SA(1, 0), Ab + kstep, aoff[0]); PG8_STAGE(PG8_SB(1, 1), cB + hstep + kstep, voffB);
    PG8_WAIT_V(6); PG8_BAR;
    for (;;) {
        const bool has_next = S.next(ui + 1, nxt);
        const bool doA1 = cur.nvalid > 128, doA0 = (wr == 0) || (cur.nvalid > 64);
        const char* nB = has_next ? S.b_ptr(nxt) : cB;
        const char* pA = Ab;
        for (int t = 0; t < nt; t += 2) {
            const bool last = (t == nt - 2);
            const char* b2 = last ? nB : cB + (size_t)(t + 2) * kstep;
            const char* b3 = b2 + kstep;
            PG8_LDB(B0, 0, 0); PG8_LDB(B1, 0, 1); PG8_SCHED; if (!SKIP || doA0) PG8_LDA(At, 0, 0); PG8_STAGE(PG8_SA(1, 1), pA + (size_t)(t + 1) * kstep, aoff[1]);
            if (last) {
                if (has_next) { PG8_LOAD_AOFF(nxt); }
                pA = Ab - (size_t)(t + 2) * kstep;
            }
            PG8_WAIT_V(8); PG8_WAIT_L(0); PG8_BAR; PG8_MMA(0, 0, At, B0); PG8_MMA(0, 1, At, B1); PG8_BAR; PG8_SCHED;
            if (!SKIP || doA1) PG8_LDA(At, 0, 1); PG8_STAGE(PG8_SB(0, 0), b2, voffB); PG8_STAGE(PG8_SB(0, 1), b2 + hstep, voffB); PG8_STAGE(PG8_SA(0, 0), pA + (size_t)(t + 2) * kstep, aoff[0]);
            PG8_WAIT_V(8); PG8_WAIT_L(0); PG8_BAR; PG8_MMA(1, 0, At, B0); PG8_MMA(1, 1, At, B1); PG8_BAR; PG8_SCHED;
            PG8_LDB(B0, 1, 0); PG8_LDB(B1, 1, 1); PG8_SCHED; if (!SKIP || doA0) PG8_LDA(At, 1, 0); PG8_STAGE(PG8_SA(0, 1), pA + (size_t)(t + 2) * kstep, aoff[1]);
            PG8_WAIT_V(8); PG8_WAIT_L(0); PG8_BAR; PG8_MMA(0, 0, At, B0); PG8_MMA(0, 1, At, B1); PG8_BAR; PG8_SCHED;
            if (!SKIP || doA1) PG8_LDA(At, 1, 1); PG8_STAGE(PG8_SB(1, 0), b3, voffB); PG8_STAGE(PG8_SB(1, 1), b3 + hstep, voffB); PG8_STAGE(PG8_SA(1, 0), pA + (size_t)(t + 3) * kstep, aoff[0]);
            PG8_WAIT_V(8); PG8_WAIT_L(0); PG8_BAR; PG8_MMA(1, 0, At, B0); PG8_MMA(1, 1, At, B1); PG8_BAR; PG8_SCHED;
        }
        if (wr == 0) PG8_BAR;
        E(acc, cur, wr, wc, fr, fq);
        if (!has_next) break;
#pragma unroll
        for (int a = 0; a < 2; ++a)
#pragma unroll
            for (int b = 0; b < 2; ++b)
#pragma unroll
                for (int m = 0; m < 4; ++m)
#pragma unroll
                    for (int n = 0; n < 2; ++n) acc[a][b][m][n] = (f32x4){0.f, 0.f, 0.f, 0.f};
        cur = nxt; cB = nB; ++ui;
        if (wr == 1) PG8_BAR;
    }
    PG8_WAIT_V(0);
    PG8_BAR;
#undef PG8_SA
#undef PG8_SB
#undef PG8_STAGE
#undef PG8_LDA
#undef PG8_LDB
#undef PG8_MMA
#undef PG8_WAIT_V
#undef PG8_WAIT_L
#undef PG8_BAR
#undef PG8_SCHED
#undef PG8_LOAD_AOFF
}

struct EpiProj {
    static constexpr bool PERM = true;
    bf16_t* O; bf16_t* QH; bf16_t* KH; bf16_t* VH; float* VSSP;
    __device__ __forceinline__ void operator()(const f32x4 (&acc)[2][2][4][2], const Unit& u, int wr, int wc, int fr, int fq) const {
        const int act = (u.pn < 16) ? 1 : ((u.pn >= 32) ? 2 : 0);
        const float sc = (u.pn >= 20 && u.pn < 24) ? 0.0625f : 1.0f;
        const int row0 = u.pm * BM + wr * 64 + fr;
        bf16_t* base = O + (size_t)u.pn * BM; size_t pitch = NPROJ; size_t hoff = 0;
        if (u.pn >= 16 && u.pn < 24) { const int hh = (u.pn - 16) & 3; base = (u.pn < 20) ? QH : KH; pitch = 256; hoff = (size_t)hh * SEQL * 256; }
        else if (u.pn >= 24 && u.pn < 32) { const int hh = (u.pn - 24) >> 1; base = VH + ((u.pn - 24) & 1) * 256; pitch = 512; hoff = (size_t)hh * SEQL * 512; }
        const int col0 = wc * 32 + 8 * fq; const bool headmajor = (u.pn >= 16 && u.pn < 32);
#pragma unroll
        for (int ai = 0; ai < 2; ++ai)
#pragma unroll
            for (int m = 0; m < 4; ++m) { const int row = row0 + ai * HALF + m * 16;
                bf16_t* rowp = headmajor ? base + (size_t)(row >> 12) * 4 * SEQL * pitch + hoff + (size_t)(row & (SEQL - 1)) * pitch + col0 : base + (size_t)row * pitch + col0;
                float vss = 0.f;
#pragma unroll
                for (int bj = 0; bj < 2; ++bj) { f32x4 v0 = acc[ai][bj][m][0], v1 = acc[ai][bj][m][1];
                    if (act == 1) {
#pragma unroll
                        for (int j = 0; j < 4; ++j) { v0[j] = gelu_tanh(v0[j]); v1[j] = gelu_tanh(v1[j]); vss += v0[j] * v0[j] + v1[j] * v1[j]; } }
                    else if (act == 2) {
#pragma unroll
                        for (int j = 0; j < 4; ++j) { v0[j] = sigmoid_f(v0[j]); v1[j] = sigmoid_f(v1[j]); } }
                    else { v0 = v0 * sc; v1 = v1 * sc; }
                    u32x4 w; w.x = cvt_pk_bf16(v0[0], v0[1]); w.y = cvt_pk_bf16(v0[2], v0[3]); w.z = cvt_pk_bf16(v1[0], v1[1]); w.w = cvt_pk_bf16(v1[2], v1[3]);
                    *(u32x4*)(rowp + bj * HALF) = w; }
                if (u.pn >= 8 && u.pn < 16) { vss += __shfl_xor(vss, 16); vss += __shfl_xor(vss, 32);
                    if (fq == 0) VSSP[(size_t)row * 32 + (u.pn - 8) * 4 + wc] = vss; } }
    }
};
struct EpiRes {
    static constexpr bool PERM = true;
    const float* base; bf16_t* out;
    __device__ __forceinline__ void operator()(const f32x4 (&acc)[2][2][4][2], const Unit& u, int wr, int wc, int fr, int fq) const {
        const int row0 = u.pm * BM + wr * 64 + fr, col0 = u.pn * BM + wc * 32 + 8 * fq;
#pragma unroll
        for (int ai = 0; ai < 2; ++ai)
#pragma unroll
            for (int m = 0; m < 4; ++m) { const size_t off = (size_t)(row0 + ai * HALF + m * 16) * DM + col0;
#pragma unroll
                for (int bj = 0; bj < 2; ++bj) { const f32x4 b0 = *(const f32x4*)(base + off + bj * HALF), b1 = *(const f32x4*)(base + off + bj * HALF + 4);
                    const f32x4 v0 = b0 + acc[ai][bj][m][0], v1 = b1 + acc[ai][bj][m][1];
                    u32x4 w; w.x = cvt_pk_bf16(v0[0], v0[1]); w.y = cvt_pk_bf16(v0[2], v0[3]); w.z = cvt_pk_bf16(v1[0], v1[1]); w.w = cvt_pk_bf16(v1[2], v1[3]);
                    *(u32x4*)(out + off + bj * HALF) = w; } }
    }
};
struct EpiGU {
    static constexpr bool PERM = true;
    bf16_t* HM; const int* list; const float* rstd2;
    __device__ __forceinline__ void operator()(const f32x4 (&acc)[2][2][4][2], const Unit& u, int wr, int wc, int fr, int fq) const {
        const int col0 = u.pn * 128 + wc * 32 + 8 * fq;
#pragma unroll
        for (int ai = 0; ai < 2; ++ai)
#pragma unroll
            for (int m = 0; m < 4; ++m) { const int rt = ai * HALF + wr * 64 + m * 16 + fr;
                if (rt < u.nvalid) {
                    const int a = list[u.e * LISTCAP + u.pm * 256 + rt]; const float rs = rstd2[a >> 1];
                    float h[8];
#pragma unroll
                    for (int n = 0; n < 2; ++n)
#pragma unroll
                        for (int j = 0; j < 4; ++j) { const float g = acc[ai][0][m][n][j] * rs, up = acc[ai][1][m][n][j] * rs; h[n * 4 + j] = g * sigmoid_f(g) * up; }
                    u32x4 w; w.x = cvt_pk_bf16(h[0], h[1]); w.y = cvt_pk_bf16(h[2], h[3]); w.z = cvt_pk_bf16(h[4], h[5]); w.w = cvt_pk_bf16(h[6], h[7]);
                    *(u32x4*)(HM + (size_t)(u.rowbase + rt) * DEXP + col0) = w; } }
    }
};
struct EpiDown {
    static constexpr bool PERM = true;
    bf16_t* YT;
    __device__ __forceinline__ void operator()(const f32x4 (&acc)[2][2][4][2], const Unit& u, int wr, int wc, int fr, int fq) const {
        const int col0 = u.pn * BM + wc * 32 + 8 * fq;
#pragma unroll
        for (int ai = 0; ai < 2; ++ai)
#pragma unroll
            for (int m = 0; m < 4; ++m) { const int rt = ai * HALF + wr * 64 + m * 16 + fr; bf16_t* rowp = YT + (size_t)(u.rowbase + rt) * DM + col0;
                if (rt < u.nvalid) {
#pragma unroll
                for (int bj = 0; bj < 2; ++bj) { const f32x4 v0 = acc[ai][bj][m][0], v1 = acc[ai][bj][m][1];
                    u32x4 w; w.x = cvt_pk_bf16(v0[0], v0[1]); w.y = cvt_pk_bf16(v0[2], v0[3]); w.z = cvt_pk_bf16(v1[0], v1[1]); w.w = cvt_pk_bf16(v1[2], v1[3]);
                    *(u32x4*)(rowp + bj * HALF) = w; } } }
    }
};
}

#define XB_TMO      128
#define XB_XCNT(j)  (256  + 64 * (j))
#define XB_XSUB(j)  (1280 + 64 * (j))
#define XB_XGEN(j)  (2304 + 64 * (j))
#define XB_TOP      3328
#define XB_TOPGEN   3392
#define XCD_BAR_WORDS 3456
#define XB_SPIN_CAP (1u << 18)
__device__ __forceinline__ unsigned xb_ld(unsigned* p)              { return __hip_atomic_load(p, __ATOMIC_RELAXED, __HIP_MEMORY_SCOPE_AGENT); }
__device__ __forceinline__ unsigned xb_add(unsigned* p, unsigned v) { return __hip_atomic_fetch_add(p, v, __ATOMIC_RELAXED, __HIP_MEMORY_SCOPE_AGENT); }
__device__ __forceinline__ unsigned xb_xcc_id() { return (unsigned)__builtin_amdgcn_s_getreg((3 << 11) | 20) & 0xFu; }
#define XB_SPIN(cond, bar) do { unsigned _sp = 0; while (cond) { __builtin_amdgcn_s_sleep(1); \
    if ((++_sp & 255u) == 0u) { if (xb_ld(&(bar)[XB_TMO])) break; if (_sp > XB_SPIN_CAP) { atomicAdd(&(bar)[XB_TMO], 1u); break; } } } } while (0)
struct XcdBarrier { unsigned* bar; unsigned x; volatile LAS unsigned* st; };
__device__ __forceinline__ XcdBarrier xcd_barrier_post(unsigned* bar, volatile LAS unsigned* st) {
    XcdBarrier b; b.bar = bar; b.x = xb_xcc_id(); b.st = st;
    if (threadIdx.x == 0) (void)xb_add(&bar[XB_XCNT(b.x)], 1u);
    return b;
}
__device__ __forceinline__ void xcd_barrier_complete(unsigned* bar, unsigned x, unsigned& nloc, unsigned& nx) {
    const unsigned G = gridDim.x * gridDim.y * gridDim.z;
    unsigned sum, cnt, mine, sp = 0u;
    for (;;) {
        sum = 0u; cnt = 0u; mine = 0u;
#pragma unroll
        for (unsigned j = 0; j < 16; ++j) { const unsigned c = xb_ld(&bar[XB_XCNT(j)]); sum += c; cnt += (c > 0u) ? 1u : 0u; mine = (j == x) ? c : mine; }
        if (sum == G) break;
        __builtin_amdgcn_s_sleep(1);
        if ((++sp & 255u) == 0u) { if (xb_ld(&bar[XB_TMO])) break; if (sp > XB_SPIN_CAP) { atomicAdd(&bar[XB_TMO], 1u); break; } }
    }
    nloc = mine > 0u ? mine : 1u; nx = cnt > 0u ? cnt : 1u;
}
__device__ __forceinline__ void xcd_barrier(const XcdBarrier& b, const bool thread0) {
    asm volatile("s_waitcnt vmcnt(0)" ::: "memory");
    __syncthreads();
    if (thread0) {
        unsigned* bar = b.bar;
        __builtin_amdgcn_s_waitcnt(0);
        unsigned nloc = b.st[0], nx = b.st[1];
        if (nloc == 0u) { xcd_barrier_complete(bar, b.x, nloc, nx); b.st[0] = nloc; b.st[1] = nx; }
        const unsigned old = xb_add(&bar[XB_XSUB(b.x)], 1u);
        const unsigned gen = old / nloc;
        if (old + 1u == (gen + 1u) * nloc) {
            __builtin_amdgcn_fence(__ATOMIC_RELEASE, "agent");
            asm volatile("s_waitcnt vmcnt(0)" ::: "memory");
            const unsigned og = xb_add(&bar[XB_TOP], 1u);
            const unsigned tg = og / nx;
            if (og + 1u == (tg + 1u) * nx) xb_add(&bar[XB_TOPGEN], 1u);
            else XB_SPIN(xb_ld(&bar[XB_TOPGEN]) == tg, bar);
            __builtin_amdgcn_fence(__ATOMIC_ACQUIRE, "agent");
            xb_add(&bar[XB_XGEN(b.x)], 1u);
            asm volatile("s_waitcnt vmcnt(0)" ::: "memory");
        } else {
            XB_SPIN(xb_ld(&bar[XB_XGEN(b.x)]) == gen, bar);
            __builtin_amdgcn_fence(__ATOMIC_ACQUIRE, "agent");
            asm volatile("s_waitcnt vmcnt(0)" ::: "memory");
        }
    }
    __syncthreads();
}

struct Frame {
    LAS unsigned char* lds;
    unsigned* ctl;
    int tid, lane, wave, vcu, G;
    const float *x, *g1, *w_in, *gvn, *gsw, *gsb, *igb, *fgb, *ogn, *w_out, *g2, *rgw, *rgb, *rew, *reb, *wg, *wu, *wd, *gf;
    float* out;
    bf16_t *WIN_T, *WOUT_T, *WGU_T, *WD_T, *WRT, *ACT, *PROJ, *YT, *HM, *QH, *KH, *VH, *PM, *KP;
    float *GATES, *RSTD2, *AW, *HB, *VSSP, *GS; bf16_t* X1; int *LIST, *APOS;
};

struct TrDesc { const float* src; bf16_t* dst; int rk0; int ldw, ldt; };
__device__ __forceinline__ int gain_off(int k) { return (k >> 9) * 16640 + 8448 + 4 * (k & 511); }
__device__ __forceinline__ void tr_load(const TrDesc& d, f32x4 (&v)[16], int lane) {
    const GAS float* wp = (const GAS float*)d.src + (size_t)(lane >> 4) * d.ldw + 4 * (lane & 15);
#pragma unroll
    for (int i = 0; i < 16; ++i) v[i] = __builtin_nontemporal_load((const GAS f32x4*)(wp + (size_t)(4 * i) * d.ldw));
}
__device__ __forceinline__ void tr_store(const TrDesc& d, const f32x4 (&v)[16], LAS float* scr, int lane, LAS unsigned char* lds) {
    LAS unsigned* sw = (LAS unsigned*)scr + (lane >> 4) * 33 + 2 * (lane & 15);
    if (d.rk0 >= 0) { const LAS float* rs = (const LAS float*)(lds + gain_off(d.rk0)) + (lane >> 4);
#pragma unroll
        for (int i = 0; i < 16; ++i) { const float s = rs[4 * i]; sw[(4 * i) * 33 + 0] = cvtpk(v[i].x * s, v[i].y * s); sw[(4 * i) * 33 + 1] = cvtpk(v[i].z * s, v[i].w * s); } }
    else {
#pragma unroll
        for (int i = 0; i < 16; ++i) { sw[(4 * i) * 33 + 0] = cvtpk(v[i].x, v[i].y); sw[(4 * i) * 33 + 1] = cvtpk(v[i].z, v[i].w); } }
    LDS_WAIT();
    const int c = lane & 7;
#pragma unroll
    for (int j = 0; j < 4; ++j) { const int dcol = (lane >> 3) + 8 * j; const LAS unsigned* sr = (const LAS unsigned*)scr + (8 * c) * 33 + dcol;
        unsigned x[8];
#pragma unroll
        for (int kk = 0; kk < 8; ++kk) x[kk] = sr[kk * 33];
        u32x4 lo, hi;
        lo.x = (x[0] & 0xffffu) | (x[1] << 16); lo.y = (x[2] & 0xffffu) | (x[3] << 16); lo.z = (x[4] & 0xffffu) | (x[5] << 16); lo.w = (x[6] & 0xffffu) | (x[7] << 16);
        hi.x = (x[0] >> 16) | (x[1] & 0xffff0000u); hi.y = (x[2] >> 16) | (x[3] & 0xffff0000u); hi.z = (x[4] >> 16) | (x[5] & 0xffff0000u); hi.w = (x[6] >> 16) | (x[7] & 0xffff0000u);
        GAS bf16_t* op = (GAS bf16_t*)d.dst + (size_t)(2 * dcol) * d.ldt + 8 * c;
        __builtin_nontemporal_store(lo, (GAS u32x4*)op); __builtin_nontemporal_store(hi, (GAS u32x4*)(op + d.ldt)); }
    LDS_WAIT();
}
__device__ __forceinline__ void phase0(Frame& F) {
    LAS float* gwl = (LAS float*)F.lds;
#pragma unroll 4
    for (int idx = F.tid; idx < 8 * 4096; idx += 512) { const int k = idx >> 3, j = idx & 7; gwl[j * 4096 + k] = F.g1[k] * F.w_in[(size_t)k * LDW_IN + NPROJ + j]; }
    __syncthreads();
    const int gw = F.vcu * 8 + F.wave, NGW = F.G * 8;
    for (int m = gw; m < NTOK; m += NGW) {
        const f32x4* xr = (const f32x4*)(F.x + (size_t)m * DM) + F.lane;
        const f32x4* gr = (const f32x4*)F.g1 + F.lane;
        asm volatile("" : "+v"(gr));
        f32x4 v[16];
#pragma unroll
        for (int j = 0; j < 16; ++j) v[j] = xr[64 * j];
        const LAS float* l0 = gwl + 4 * F.lane; const LAS float* l1 = l0 + 4 * 4096;
        asm volatile("" : "+v"(l0), "+v"(l1));
        float ss = 0.f; float ga[8];
#pragma unroll
        for (int c = 0; c < 8; ++c) ga[c] = 0.f;
#pragma unroll
        for (int j = 0; j < 16; ++j) { const f32x4 y = v[j]; ss += (y.x * y.x + y.y * y.y) + (y.z * y.z + y.w * y.w);
#pragma unroll
            for (int c = 0; c < 4; ++c) { const f32x4 w = *(const LAS f32x4*)(l0 + 256 * j + c * 4096); ga[c] += (y.x * w.x + y.y * w.y) + (y.z * w.z + y.w * w.w); }
#pragma unroll
            for (int c = 0; c < 4; ++c) { const f32x4 w = *(const LAS f32x4*)(l1 + 256 * j + c * 4096); ga[4 + c] += (y.x * w.x + y.y * w.y) + (y.z * w.z + y.w * w.w); }
            }
        ss = wave_sum(ss);
        const float rstd = 1.0f / sqrtf(ss * (1.0f / DM) + EPS);
#pragma unroll
        for (int c = 0; c < 8; ++c) ga[c] = wave_sum(ga[c]) * rstd;
        if (F.lane == 0) { f32x4* gp = (f32x4*)(F.GATES + (size_t)m * 8); gp[0] = (f32x4){ga[0], ga[1], ga[2], ga[3]}; gp[1] = (f32x4){ga[4], ga[5], ga[6], ga[7]}; }
        u32x2* o8 = (u32x2*)(F.ACT + (size_t)m * DM) + F.lane;
#pragma unroll
        for (int j = 0; j < 16; ++j) { const f32x4 y = v[j] * rstd * gr[64 * j]; u32x2 o; o.x = cvtpk(y.x, y.y); o.y = cvtpk(y.z, y.w); o8[64 * j] = o; }
    }
    __syncthreads();
}
constexpr int I_IN = 64 * 160, I_OUT = 64 * 64, I_G = 64 * 512, I_U = I_G, I_D = 64 * 512;
constexpr int NITEMS = I_IN + I_OUT + I_G + I_U + I_D, ITEMS_DENSE = I_IN;
constexpr int NCONV = 72;
__device__ __forceinline__ void phase_convert(Frame& F, const int it_lo, const int it_hi, const int gw, const int NGW) {
    LAS float* scr = (LAS float*)(F.lds + F.wave * 16640);
    if (it_hi > ITEMS_DENSE + I_OUT) { __syncthreads(); for (int k = F.tid; k < DM; k += 512) *(LAS float*)(F.lds + gain_off(k)) = F.g2[k]; __syncthreads(); }
    auto decode = [&](int it) -> TrDesc {
        TrDesc d; int r = it;
        if (r < I_IN) { const int kb = r & 63, nb = r >> 6;   d.src = F.w_in + (size_t)(64 * kb) * LDW_IN + 64 * nb; d.rk0 = -1; d.ldw = LDW_IN; d.dst = F.WIN_T + (size_t)(64 * nb) * DM + 64 * kb; d.ldt = DM; return d; } r -= I_IN;
        if (r < I_OUT) { const int kb = r & 63, nb = r >> 6; d.src = F.w_out + (size_t)(64 * kb) * DM + 64 * nb; d.rk0 = -1; d.ldw = DM; d.dst = F.WOUT_T + (size_t)(64 * nb) * DM + 64 * kb; d.ldt = DM; return d; } r -= I_OUT;
        if (r < I_G + I_U) { const int up = (r >= I_G) ? 1 : 0; r -= up * I_G; const int e = r >> 9, q = r & 511, kb = (q >> 6) * 8 + (q & 7), n0 = ((q >> 3) & 7) * 64; const int drow = (n0 >> 7) * 256 + up * 128 + (n0 & 127);
            d.src = (up ? F.wu : F.wg) + (size_t)e * DM * DEXP + (size_t)(64 * kb) * DEXP + n0; d.rk0 = 64 * kb; d.ldw = DEXP; d.dst = F.WGU_T + (size_t)e * 1024 * DM + (size_t)drow * DM + 64 * kb; d.ldt = DM; return d; } r -= I_G + I_U;
        { const int e = r >> 9, q = r & 511, kb = q & 7, nb = q >> 3;
            d.src = F.wd + (size_t)e * DEXP * DM + (size_t)(64 * kb) * DM + 64 * nb; d.rk0 = -1; d.ldw = DM; d.dst = F.WD_T + (size_t)e * DM * DEXP + (size_t)(64 * nb) * DEXP + 64 * kb; d.ldt = DEXP; return d; }
    };
    if (NGW < 0) {
        const int per = (it_hi - it_lo + (-NGW) - 1) / (-NGW); int it = it_lo + gw * per; const int ie = (it + per < it_hi) ? it + per : it_hi;
        f32x4 va[16], vb[16], vc[16]; TrDesc da, db, dc;
        if (it < ie) { da = decode(it); tr_load(da, va, F.lane); }
        if (it + 1 < ie) { db = decode(it + 1); tr_load(db, vb, F.lane); }
        for (; it < ie; it += 3) {
            if (it + 2 < ie) { dc = decode(it + 2); tr_load(dc, vc, F.lane); }
            tr_store(da, va, scr, F.lane, F.lds);
            if (it + 1 >= ie) break;
            if (it + 3 < ie) { da = decode(it + 3); tr_load(da, va, F.lane); }
            tr_store(db, vb, scr, F.lane, F.lds);
            if (it + 2 >= ie) break;
            if (it + 4 < ie) { db = decode(it + 4); tr_load(db, vb, F.lane); }
            tr_store(dc, vc, scr, F.lane, F.lds);
        }
        return; }
    { f32x4 va[16], vb[16]; TrDesc d0, d1; int it = it_lo + gw;
      if (it < it_hi) { d0 = decode(it); tr_load(d0, va, F.lane); }
      for (; it < it_hi; it += NGW) {
          const bool has = (it + NGW) < it_hi;
          if (has) { d1 = decode(it + NGW); tr_load(d1, vb, F.lane); }
          tr_store(d0, va, scr, F.lane, F.lds);
          if (has) { d0 = d1;
#pragma unroll
              for (int i = 0; i < 16; ++i) va[i] = vb[i]; }
      } }
}
__device__ __forceinline__ void phase0b(Frame& F) {
    phase_convert(F, 0, ITEMS_DENSE, F.vcu * 8 + F.wave, F.G * 8);
#pragma unroll 2
    for (int idx = F.vcu * 512 + F.tid; idx < 80 * 4096; idx += F.G * 512) { const int n = idx >> 12, k = idx & 4095;
        const float v = (n < 8) ? F.rgw[k * 8 + n] : ((n < 72) ? F.rew[k * 64 + (n - 8)] : 0.f); F.WRT[idx] = (bf16_t)f2bf(v * F.g2[k]); }
}

typedef short v4i16_t __attribute__((ext_vector_type(4)));
__device__ __forceinline__ bf16x8 tr_bfrag(const LAS bf16_t* p0, const LAS bf16_t* p1) {
    const v4i16_t a = __builtin_amdgcn_ds_read_tr16_b64_v4i16((LAS v4i16_t*)p0), b = __builtin_amdgcn_ds_read_tr16_b64_v4i16((LAS v4i16_t*)p1);
    bf16x8 o; o[0] = a[0]; o[1] = a[1]; o[2] = a[2]; o[3] = a[3]; o[4] = b[0]; o[5] = b[1]; o[6] = b[2]; o[7] = b[3]; return o;
}
__device__ __forceinline__ void phase_gmlp(Frame& F) {
    LAS bf16_t* Wl = (LAS bf16_t*)(F.lds);
    LAS bf16_t* VT = (LAS bf16_t*)(F.lds + 34816);
    LAS float* rs = (LAS float*)(F.lds + 69632);
    LAS float* Zt = (LAS float*)(F.lds + 70144);
    const int r = F.lane & 15, g4 = F.lane >> 4;
    for (int unit = blockIdx.x; unit < 512; unit += F.G) {
        const int g = unit & 15, cb = unit >> 4;
#pragma unroll
        for (int i = 0; i < 8; ++i) { const int idx = F.tid + 512 * i, t = idx >> 5, sc = (idx & 31) * 4;
            f32x4 w = *(const f32x4*)(F.gsw + (size_t)g * 16384 + t * 128 + sc);
            w.x = (sc + 0 <= t) ? w.x : 0.f; w.y = (sc + 1 <= t) ? w.y : 0.f; w.z = (sc + 2 <= t) ? w.z : 0.f; w.w = (sc + 3 <= t) ? w.w : 0.f;
            u32x2 o; o.x = cvtpk(w.x, w.y); o.y = cvtpk(w.z, w.w); *(LAS u32x2*)(Wl + t * 136 + sc) = o; }
        u32x4 vraw[4], uraw[4]; f32x4 pp[8];
#define GM_PREFETCH_V(chn) do { const int r0n = (4 * cb + (chn)) * 128; \
            _Pragma("unroll") for (int i = 0; i < 4; ++i) { const int idx_ = F.tid + 512 * i; vraw[i] = *(const u32x4*)(F.PROJ + (size_t)(r0n + (idx_ >> 4)) * NPROJ + C_V + g * 128 + (idx_ & 15) * 8); } \
            if (F.tid < 128) { const f32x4* pq = (const f32x4*)(F.VSSP + (size_t)(r0n + F.tid) * 32); _Pragma("unroll") for (int q = 0; q < 8; ++q) pp[q] = pq[q]; } } while (0)
        GM_PREFETCH_V(0);
        LDS_BARRIER();
#pragma unroll
        for (int ch = 0; ch < 4; ++ch) {
            const int r0 = (4 * cb + ch) * 128;
            if (F.tid < 128) { float ss = 0.f;
#pragma unroll
                for (int q = 0; q < 8; ++q) ss += (pp[q].x + pp[q].y) + (pp[q].z + pp[q].w);
                rs[F.tid] = 1.0f / sqrtf(ss * (1.0f / 2048.0f) + EPS); }
            LDS_BARRIER();
            { const int d8 = (F.tid & 15) * 8;
              const f32x4 gva = *(const f32x4*)(F.gvn + g * 128 + d8), gvb = *(const f32x4*)(F.gvn + g * 128 + d8 + 4);
#pragma unroll
              for (int i = 0; i < 4; ++i) { const int t = (F.tid >> 4) + 32 * i; const float scl = rs[t];
                const u32x4 raw = vraw[i]; const f32x4 ga = gva * scl, gb = gvb * scl;
                u32x4 o; o.x = cvtpk(bf_lo(raw.x) * ga.x, bf_hi(raw.x) * ga.y); o.y = cvtpk(bf_lo(raw.y) * ga.z, bf_hi(raw.y) * ga.w); o.z = cvtpk(bf_lo(raw.z) * gb.x, bf_hi(raw.z) * gb.y); o.w = cvtpk(bf_lo(raw.w) * gb.z, bf_hi(raw.w) * gb.w);
                *(LAS u32x4*)(VT + t * 136 + d8) = o; } }
#pragma unroll
            for (int i = 0; i < 4; ++i) { const int idx = F.tid + 512 * i; uraw[i] = *(const u32x4*)(F.PROJ + (size_t)(r0 + (idx >> 4)) * NPROJ + C_U + g * 128 + (idx & 15) * 8); }
            if (ch + 1 < 4) GM_PREFETCH_V(ch + 1);
            LDS_BARRIER();
            const int t0 = 16 * F.wave, nks = (F.wave >> 1) + 1;
            f32x4 acc[8];
#pragma unroll
            for (int dt = 0; dt < 8; ++dt) acc[dt] = (f32x4){0.f, 0.f, 0.f, 0.f};
            for (int ks = 0; ks < nks; ++ks) {
                const bf16x8 A = *(const LAS bf16x8*)(Wl + (t0 + r) * 136 + 32 * ks + 8 * g4);
                bf16x8 B[8];
#pragma unroll
                for (int dt = 0; dt < 8; ++dt) { const LAS bf16_t* bp = VT + (32 * ks + 8 * g4 + (r >> 2)) * 136 + 16 * dt + 4 * (r & 3); B[dt] = tr_bfrag(bp, bp + 4 * 136); }
                __builtin_amdgcn_sched_barrier(0);
#pragma unroll
                for (int dt = 0; dt < 8; ++dt) acc[dt] = mfma16(A, B[dt], acc[dt]);
                __builtin_amdgcn_sched_barrier(0); }
#pragma unroll
            for (int rr = 0; rr < 4; ++rr) { const int t = t0 + 4 * g4 + rr; const float bias = F.gsb[g * 128 + t];
#pragma unroll
                for (int dt = 0; dt < 8; ++dt) Zt[t * 132 + 16 * dt + r] = acc[dt][rr] + bias; }
            LDS_BARRIER();
#pragma unroll
            for (int i = 0; i < 4; ++i) { const int idx = F.tid + 512 * i, t = idx >> 4, d8 = (idx & 15) * 8;
                const u32x4 uu = uraw[i];
                const f32x4 z0 = *(const LAS f32x4*)(Zt + t * 132 + d8), z1 = *(const LAS f32x4*)(Zt + t * 132 + d8 + 4);
                u32x4 o; o.x = cvtpk(bf_lo(uu.x) * z0.x, bf_hi(uu.x) * z0.y); o.y = cvtpk(bf_lo(uu.y) * z0.z, bf_hi(uu.y) * z0.w); o.z = cvtpk(bf_lo(uu.z) * z1.x, bf_hi(uu.z) * z1.y); o.w = cvtpk(bf_lo(uu.w) * z1.z, bf_hi(uu.w) * z1.w);
                *(u32x4*)(F.ACT + (size_t)(r0 + t) * DM + g * 128 + d8) = o; }
        }
#undef GM_PREFETCH_V
        __syncthreads();
    }
}

__device__ __forceinline__ float softcap15(float z) { return 15.0f * tanhf(z * (1.0f / 15.0f)); }
__device__ __forceinline__ void phase_gates(Frame& F, const int bh) {
    LAS float* SA = (LAS float*)(F.lds);
    LAS float* SM = (LAS float*)(F.lds + 16384);
    LAS float* SFL = (LAS float*)(F.lds + 32768);
    LAS float* scr = (LAS float*)(F.lds + 134144);
    const int tid = F.tid, lane = F.lane, wave = F.wave, b = bh >> 2, hh = bh & 3, rowb = b * SEQL;
    __syncthreads();
        { const float igb = F.igb[hh], fgb = F.fgb[hh];
          float cs[8], av[8]; float run = 0.f;
          float gi8[8], gf8[8];
#pragma unroll
          for (int k = 0; k < 8; ++k) { const float* gp = F.GATES + (size_t)(rowb + 8 * tid + k) * 8; gi8[k] = gp[hh]; gf8[k] = gp[4 + hh]; }
#pragma unroll
          for (int k = 0; k < 8; ++k) { const float zf = softcap15(gf8[k] + fgb); run += -log1pf(expf(-zf)); cs[k] = run; av[k] = softcap15(gi8[k] + igb); }
          float incl = run;
#pragma unroll
          for (int o = 1; o < 64; o <<= 1) { const float t = __shfl_up(incl, o); if (lane >= o) incl += t; }
          if (lane == 63) scr[wave] = incl;
          __syncthreads();
          float base = incl - run;
          for (int w = 0; w < wave; ++w) base += scr[w];
          float Bv[8]; float runm = -3.0e38f; float mx[8];
#pragma unroll
          for (int k = 0; k < 8; ++k) { Bv[k] = base + cs[k]; av[k] = av[k] - Bv[k]; runm = fmaxf(runm, av[k]); mx[k] = runm; }
          float inclm = runm;
#pragma unroll
          for (int o = 1; o < 64; o <<= 1) { const float t = __shfl_up(inclm, o); if (lane >= o) inclm = fmaxf(inclm, t); }
          float exclm = __shfl_up(inclm, 1); if (lane == 0) exclm = -3.0e38f;
          if (lane == 63) scr[8 + wave] = inclm;
          __syncthreads();
          float basem = fmaxf(0.f, exclm);
          for (int w = 0; w < wave; ++w) basem = fmaxf(basem, scr[8 + w]);
          float Mv[8], flv[8];
#pragma unroll
          for (int k = 0; k < 8; ++k) { Mv[k] = fmaxf(basem, mx[k]); flv[k] = expf(-(Bv[k] + Mv[k])); }
          *(LAS f32x4*)(SA + 8 * tid) = (f32x4){av[0], av[1], av[2], av[3]}; *(LAS f32x4*)(SA + 8 * tid + 4) = (f32x4){av[4], av[5], av[6], av[7]};
          *(LAS f32x4*)(SM + 8 * tid) = (f32x4){Mv[0], Mv[1], Mv[2], Mv[3]}; *(LAS f32x4*)(SM + 8 * tid + 4) = (f32x4){Mv[4], Mv[5], Mv[6], Mv[7]};
          *(LAS f32x4*)(SFL + 8 * tid) = (f32x4){flv[0], flv[1], flv[2], flv[3]}; *(LAS f32x4*)(SFL + 8 * tid + 4) = (f32x4){flv[4], flv[5], flv[6], flv[7]}; }
    __syncthreads();
    { f32x4* gs = (f32x4*)(F.GS + (size_t)bh * 3 * 4096);
#pragma unroll
      for (int i = 0; i < 6; ++i) gs[tid + 512 * i] = *(const LAS f32x4*)(SA + 4 * (tid + 512 * i)); }
    __syncthreads();
}
__device__ __forceinline__ void phase_mlstm_pre(Frame& F) {
    LAS bf16_t* Kc = (LAS bf16_t*)(F.lds);
    LAS bf16_t* Qc = (LAS bf16_t*)(F.lds + 67584);
    const int wave = F.wave, pp = (wave < 4) ? wave : 7 - wave, hi = wave >> 2;
    for (int unit = F.vcu; unit < 256; unit += F.G) {
        const int bh = unit >> 4, es = unit & 15;
        int ln_ = F.lane; asm volatile("" : "+v"(ln_));
        const int r = ln_ & 15, g4 = ln_ >> 4, tid = wave * 64 + ln_;
        const float* ga = F.GS + (size_t)bh * 3 * 4096; const float* gm = ga + 4096;
        u32x4 kreg[8], qreg[8];
#define MP_LOAD(c) do { const char* kb_ = (const char*)(F.KH + (size_t)bh * SEQL * 256) + (size_t)(c) * 65536; const char* qb_ = (const char*)(F.QH + (size_t)bh * SEQL * 256) + (size_t)(c) * 65536; \
        _Pragma("unroll") for (int i = 0; i < 8; ++i) { kreg[i] = *(const u32x4*)(kb_ + 8192 * i + 16u * (unsigned)tid); qreg[i] = *(const u32x4*)(qb_ + 8192 * i + 16u * (unsigned)tid); } } while (0)
        MP_LOAD(es * 2);
        for (int t = 0; t < 2; ++t) {
            const int c = es * 2 + t, pb = 128 * c;
            char* kp_ = (char*)(F.KP + (size_t)bh * SEQL * 256) + (size_t)c * 65536;
            const float Mend = gm[pb + 127];
            __syncthreads();
#pragma unroll
            for (int i = 0; i < 8; ++i) { const int rowo = 16 * i;
                *(LAS u32x4*)(Kc + (tid >> 5) * 264 + 8 * (tid & 31) + rowo * 264) = kreg[i]; *(LAS u32x4*)(Qc + (tid >> 5) * 264 + 8 * (tid & 31) + rowo * 264) = qreg[i];
                const float wt = fast_exp(ga[pb + (tid >> 5) + rowo] - Mend); u32x4 kw;
                kw.x = cvtpk(bf_lo(kreg[i].x) * wt, bf_hi(kreg[i].x) * wt); kw.y = cvtpk(bf_lo(kreg[i].y) * wt, bf_hi(kreg[i].y) * wt); kw.z = cvtpk(bf_lo(kreg[i].z) * wt, bf_hi(kreg[i].z) * wt); kw.w = cvtpk(bf_lo(kreg[i].w) * wt, bf_hi(kreg[i].w) * wt);
                *(u32x4*)(kp_ + 8192 * i + 16u * (unsigned)tid) = kw; }
            LDS_BARRIER();
            if (t == 0) MP_LOAD(c + 1);
#pragma unroll
            for (int part = 0; part < 2; ++part) {
                const int rt = part ? 7 - pp : pp;
                const int jlo = part ? (hi ? 4 - pp : 0) : 0, jhi = part ? (hi ? 7 - pp : 3 - pp) : (hi ? -1 : pp);
                if (jlo <= jhi) {
                    const int i0 = 16 * rt;
                    bf16x8 Qf[8];
#pragma unroll
                    for (int ks = 0; ks < 8; ++ks) Qf[ks] = *(const LAS bf16x8*)(Qc + (i0 + r) * 264 + 32 * ks + 8 * g4);
                    bf16_t* Pg = F.PM + ((size_t)bh * 32 + c) * 16384 + (size_t)(i0 + r) * 128 + 4 * g4;
                    const float Mi = gm[pb + i0 + r]; const int irow = i0 + r;
                    for (int jt = jlo; jt <= jhi; ++jt) {
                        bf16x8 Kf[8];
#pragma unroll
                        for (int ks = 0; ks < 8; ++ks) Kf[ks] = *(const LAS bf16x8*)(Kc + (16 * jt + r) * 264 + 32 * ks + 8 * g4);
                        const f32x4 a4 = *(const f32x4*)(ga + pb + 16 * jt + 4 * g4);
                        __builtin_amdgcn_sched_barrier(0);
                        f32x4 sv = (f32x4){0.f, 0.f, 0.f, 0.f};
#pragma unroll
                        for (int ks = 0; ks < 8; ++ks) sv = mfma16(Kf[ks], Qf[ks], sv);
                        __builtin_amdgcn_sched_barrier(0);
                        float p[4];
#pragma unroll
                        for (int rr = 0; rr < 4; ++rr) p[rr] = (16 * jt + 4 * g4 + rr <= irow) ? sv[rr] * fast_exp(a4[rr] - Mi) : 0.f;
                        u32x2 w; w.x = cvtpk(p[0], p[1]); w.y = cvtpk(p[2], p[3]);
                        *(u32x2*)(Pg + 16 * jt) = w; }
                    if (jhi == rt && (rt & 1) == 0) *(u32x2*)(Pg + 16 * (rt + 1)) = (u32x2){0u, 0u};
                } }
        }
#undef MP_LOAD
    }
    __syncthreads();
}
__device__ __forceinline__ void phase_mlstm(Frame& F) {
    LAS float* SM = (LAS float*)(F.lds);
    LAS float* SFL = (LAS float*)(F.lds + 16384);
    LAS bf16_t* Kc = (LAS bf16_t*)(F.lds + 32768);
    LAS bf16_t* CT = (LAS bf16_t*)(F.lds + 100352);
    LAS bf16_t* NV = (LAS bf16_t*)(F.lds + 117248);
    LAS bf16_t* Vc = (LAS bf16_t*)(F.lds + 117760);
    const int wave = F.wave;
    const int rt = (wave < 4) ? wave : 11 - wave, i0 = 16 * rt, nks = (rt >> 1) + 1, et = wave >> 2, dq = wave & 3;
    for (int unit = F.vcu; unit < 256; unit += F.G) {
        const int b = unit >> 6, hh = (unit >> 4) & 3, es = unit & 15, e0 = es * 32, bh = b * 4 + hh;
        const int rowb = b * SEQL;
        int ln_ = F.lane; asm volatile("" : "+v"(ln_));
        const int r = ln_ & 15, g4 = ln_ >> 4, tid = wave * 64 + ln_;
        __syncthreads();
        { const f32x4* gs = (const f32x4*)(F.GS + (size_t)bh * 3 * 4096 + 4096);
#pragma unroll
          for (int i = 0; i < 4; ++i) *(LAS f32x4*)(SM + 4 * (tid + 512 * i)) = gs[tid + 512 * i]; }
        for (int idx = tid; idx < 32 * 264; idx += 512) CT[idx] = 0;
        if (tid < 256) NV[tid] = 0;
        __syncthreads();
        const char* Kp = (const char*)(F.KP + (size_t)bh * SEQL * 256); const unsigned kvo = 16u * (unsigned)tid;
        const char* Vp = (const char*)(F.VH + (size_t)bh * SEQL * 512 + e0); const unsigned vvo = (unsigned)((tid >> 2) * 1024 + (tid & 3) * 16);
        const char* Qp = (const char*)(F.QH + (size_t)bh * SEQL * 256) + i0 * 512; const unsigned qvo = (unsigned)(r * 512 + 16 * g4);
        const char* Pp = (const char*)(F.PM + (size_t)bh * 32 * 16384) + i0 * 256; const unsigned pvo = (unsigned)(r * 256 + 16 * g4);
        f32x4 accC[4], accN[4];
#pragma unroll
        for (int dd = 0; dd < 4; ++dd) { accC[dd] = (f32x4){0.f, 0.f, 0.f, 0.f}; accN[dd] = (f32x4){0.f, 0.f, 0.f, 0.f}; }
        u32x4 kreg[8], vreg, Qr[8], Pr[4];
#pragma unroll
        for (int ks = 0; ks < 4; ++ks) Pr[ks] = (u32x4){0u, 0u, 0u, 0u};
#define ML_LOADKA(c) do { const char* kb_ = Kp + (size_t)(c) * 65536; _Pragma("unroll") for (int i = 0; i < 4; ++i) kreg[i] = *(const u32x4*)(kb_ + 8192 * i + kvo); vreg = *(const u32x4*)(Vp + (size_t)(c) * 131072 + vvo); } while (0)
#define ML_LOADKB(c) do { const char* kb_ = Kp + (size_t)(c) * 65536; _Pragma("unroll") for (int i = 4; i < 8; ++i) kreg[i] = *(const u32x4*)(kb_ + 8192 * i + kvo); } while (0)
#define ML_LOADKV(c) do { ML_LOADKA(c); ML_LOADKB(c); } while (0)
#define ML_LOADQ(c) do { const char* qb_ = Qp + (size_t)(c) * 65536; _Pragma("unroll") for (int ks = 0; ks < 8; ++ks) Qr[ks] = *(const u32x4*)(qb_ + 64 * ks + qvo); } while (0)
#define ML_LOADP(c) do { const char* pb_ = Pp + (size_t)(c) * 32768; _Pragma("unroll") for (int ks = 0; ks < 4; ++ks) if (ks < nks) Pr[ks] = *(const u32x4*)(pb_ + 64 * ks + pvo); } while (0)
        ML_LOADKV(0); ML_LOADQ(0); ML_LOADP(0);
        unsigned qtouch = 0u; const unsigned qto = (unsigned)((ln_ >> 2) * 512 + (ln_ & 3) * 128);
        qtouch = *(const unsigned*)(Qp + (size_t)1 * 65536 + qto);
        __builtin_amdgcn_s_waitcnt(0);
        for (int c = 0; c < 32; ++c) {
            const int pb = 128 * c;
#pragma unroll
            for (int i = 0; i < 8; ++i) *(LAS u32x4*)(Kc + (tid >> 5) * 264 + 8 * (tid & 31) + i * (16 * 264)) = kreg[i];
            *(LAS u32x4*)(Vc + (tid >> 2) * 48 + 8 * (tid & 3)) = vreg;
            LDS_BARRIER();
            if (c + 1 < 32) { ML_LOADKA(c + 1); }
            asm volatile("" :: "v"(qtouch));
            if (c + 2 < 32) qtouch = *(const unsigned*)(Qp + (size_t)(c + 2) * 65536 + qto);
            const float Rc = (c == 0) ? 0.f : SM[pb - 1]; const float Rn = SM[pb + 127]; const float decay = fast_exp(Rc - Rn);
            const bf16x8 ones = (bf16x8){(short)0x3f80, (short)0x3f80, (short)0x3f80, (short)0x3f80, (short)0x3f80, (short)0x3f80, (short)0x3f80, (short)0x3f80};
            {
#pragma unroll
              for (int dd = 0; dd < 4; ++dd) { accC[dd] = accC[dd] * decay; accN[dd] = accN[dd] * decay; }
#pragma unroll
              for (int ks = 0; ks < 4; ++ks) { bf16x8 Kb[4];
                  const LAS bf16_t* wp = Vc + (32 * ks + 8 * g4 + (r >> 2)) * 48 + 16 * et + 4 * (r & 3); const bf16x8 Aw = tr_bfrag(wp, wp + 4 * 48);
                  const LAS bf16_t* kp = Kc + (32 * ks + 8 * g4 + (r >> 2)) * 264 + 64 * dq + 4 * (r & 3);
#pragma unroll
                  for (int dd = 0; dd < 4; ++dd) Kb[dd] = tr_bfrag(kp + 16 * dd, kp + 4 * 264 + 16 * dd);
#pragma unroll
                  for (int dd = 0; dd < 4; ++dd) accC[dd] = mfma16(Kb[dd], Aw, accC[dd]);
                  if (et == 0) {
#pragma unroll
                      for (int dd = 0; dd < 4; ++dd) accN[dd] = mfma16(Kb[dd], ones, accN[dd]); } }
            }
            __builtin_amdgcn_sched_barrier(0);
            bf16x8 R[8];
#pragma unroll
            for (int ks = 0; ks < 8; ++ks) R[ks] = *(const LAS bf16x8*)(CT + r * 264 + 32 * ks + 8 * g4);
            f32x4 o1a = (f32x4){0.f, 0.f, 0.f, 0.f}, o1b = o1a, o2a = o1a, o2b = o1a, qn = o1a, dsum = o1a;
            __builtin_amdgcn_sched_barrier(0);
#define ML_SEG(MF, NEXTREAD) do { _Pragma("unroll") for (int ks = 0; ks < 8; ++ks) { MF; NEXTREAD; __builtin_amdgcn_sched_barrier(0); } } while (0)
            ML_SEG(o2a = mfma16(__builtin_bit_cast(bf16x8, Qr[ks]), R[ks], o2a), R[ks] = *(const LAS bf16x8*)(CT + (16 + r) * 264 + 32 * ks + 8 * g4));
            ML_SEG(o2b = mfma16(__builtin_bit_cast(bf16x8, Qr[ks]), R[ks], o2b), R[ks] = *(const LAS bf16x8*)(NV + 32 * ks + 8 * g4));
            { const LAS bf16_t* vp = Vc + (8 * g4 + (r >> 2)) * 48 + 4 * (r & 3);
#pragma unroll
              for (int ks = 0; ks < 4; ++ks) if (ks < nks) { const bf16x8 Ap = __builtin_bit_cast(bf16x8, Pr[ks]);
                  const bf16x8 Bva = tr_bfrag(vp + 32 * ks * 48, vp + (32 * ks + 4) * 48), Bvb = tr_bfrag(vp + 32 * ks * 48 + 16, vp + (32 * ks + 4) * 48 + 16);
                  o1a = mfma16(Ap, Bva, o1a); o1b = mfma16(Ap, Bvb, o1b); dsum = mfma16(Ap, ones, dsum); } }
            __builtin_amdgcn_sched_barrier(0);
            if (c + 1 < 32) { ML_LOADP(c + 1); }
            ML_SEG(qn = mfma16(__builtin_bit_cast(bf16x8, Qr[ks]), R[ks], qn), (void)0);
#undef ML_SEG
            __builtin_amdgcn_sched_barrier(0);
            if (c + 1 < 32) { ML_LOADKB(c + 1); ML_LOADQ(c + 1); }
            { const f32x4 Mi4 = *(const LAS f32x4*)(SM + pb + i0 + 4 * g4), fl4 = *(const LAS f32x4*)(SFL + pb + i0 + 4 * g4);
              char* hb_ = (char*)(F.HB + (size_t)(rowb + pb + i0) * 2048 + hh * 512 + e0); const unsigned hvoff = (unsigned)(4 * g4) * 8192u + 4u * (unsigned)r;
#pragma unroll
              for (int rr = 0; rr < 4; ++rr) { const float wir = fast_exp(Rc - Mi4[rr]);
                  const float den = wir * qn[rr] + dsum[rr]; const float inv = __builtin_amdgcn_rcpf(fmaxf(fabsf(den), fl4[rr]));
                  *(float*)(hb_ + (hvoff + 8192u * rr)) = (o1a[rr] + wir * o2a[rr]) * inv; *(float*)(hb_ + (hvoff + 8192u * rr) + 64) = (o1b[rr] + wir * o2b[rr]) * inv; } }
            {
              LDS_BARRIER();
#pragma unroll
              for (int dd = 0; dd < 4; ++dd) { u32x2 cw; cw.x = cvtpk(accC[dd][0], accC[dd][1]); cw.y = cvtpk(accC[dd][2], accC[dd][3]);
                  *(LAS u32x2*)(CT + (16 * et + r) * 264 + 16 * (4 * dq + dd) + 4 * g4) = cw; }
              if (et == 0 && r == 0) {
#pragma unroll
                  for (int dd = 0; dd < 4; ++dd) { u32x2 nw; nw.x = cvtpk(accN[dd][0], accN[dd][1]); nw.y = cvtpk(accN[dd][2], accN[dd][3]); *(LAS u32x2*)(NV + 16 * (4 * dq + dd) + 4 * g4) = nw; } } }
        }
#undef ML_LOADKV
#undef ML_LOADKA
#undef ML_LOADKB
#undef ML_LOADQ
#undef ML_LOADP
        __syncthreads();
    }
}
__device__ __forceinline__ void phase_mlnorm(Frame& F) {
    const int gw = F.vcu * 8 + F.wave, NGW = F.G * 8;
    for (int m = gw; m < NTOK; m += NGW) {
#pragma unroll
        for (int hh = 0; hh < 4; ++hh) {
            const f32x4* hp = (const f32x4*)(F.HB + (size_t)m * 2048 + hh * 512) + F.lane;
            const f32x4 v0 = hp[0], v1 = hp[64];
            float ss = (v0.x * v0.x + v0.y * v0.y) + (v0.z * v0.z + v0.w * v0.w) + (v1.x * v1.x + v1.y * v1.y) + (v1.z * v1.z + v1.w * v1.w);
            ss = wave_sum(ss);
            const float rstd = 1.0f / sqrtf(ss * (1.0f / 512.0f) + EPS);
            const f32x4* gp = (const f32x4*)(F.ogn + hh * 512) + F.lane; const f32x4 g0 = gp[0], g1 = gp[64];
            const u32x2* op = (const u32x2*)(F.PROJ + (size_t)m * NPROJ + C_O + hh * 512) + F.lane; const u32x2 s0 = op[0], s1 = op[64];
            u32x2* yp = (u32x2*)(F.ACT + (size_t)m * DM + 2048 + hh * 512) + F.lane;
            u32x2 o;
            o.x = pk2(v0.x * rstd * g0.x * bf_lo(s0.x), v0.y * rstd * g0.y * bf_hi(s0.x)); o.y = pk2(v0.z * rstd * g0.z * bf_lo(s0.y), v0.w * rstd * g0.w * bf_hi(s0.y)); yp[0] = o;
            o.x = pk2(v1.x * rstd * g1.x * bf_lo(s1.x), v1.y * rstd * g1.y * bf_hi(s1.x)); o.y = pk2(v1.z * rstd * g1.z * bf_lo(s1.y), v1.w * rstd * g1.w * bf_hi(s1.y)); yp[64] = o;
        }
    }
}

__device__ __forceinline__ void phase_router(Frame& F) {
    const int lane = F.lane, tid = F.tid, r = lane & 15, g4 = lane >> 4, pair = F.wave >> 1, half = F.wave & 1;
    LAS unsigned char* Bb = F.lds;
    LAS float* lg = (LAS float*)(F.lds + 40960) + F.wave * (16 * 81 + 16);
    for (int task = F.vcu * 4 + pair; task < NTOK / 16; task += F.G * 4) {
        const int row0 = task * 16;
        const bf16_t* xrow = F.X1 + (size_t)(row0 + r) * DM + half * 64 + 8 * g4;
        const int rotc = (F.vcu * 5) & 31;
        f32x4 acc[5];
#pragma unroll
        for (int nt = 0; nt < 5; ++nt) acc[nt] = (f32x4){0.f, 0.f, 0.f, 0.f};
        float ss = 0.f;
        u32x4 bst[3], x0[2], x1[2], x2[2], x3[2];
#define RT_KC(cc) (((cc) + rotc) & 31)
#define RT_BLOAD(cc) do { const bf16_t* wp_ = F.WRT + (size_t)RT_KC(cc) * 128; _Pragma("unroll") for (int q = 0; q < 3; ++q) { const int gc = tid + 512 * q; \
            if (gc < 1280) bst[q] = *(const u32x4*)(wp_ + (size_t)(gc >> 4) * DM + (gc & 15) * 8); } } while (0)
#define RT_BWRITE(buf) do { _Pragma("unroll") for (int q = 0; q < 3; ++q) { const int gc = tid + 512 * q, rw = gc >> 4, ch = gc & 15; \
            if (gc < 1280) *(LAS u32x4*)(Bb + (buf) * 20480 + rw * 256 + ((ch ^ (rw & 15)) << 4)) = bst[q]; } } while (0)
#define RT_XLOAD(X, cc) do { const bf16_t* xp_ = xrow + (size_t)RT_KC(cc) * 128; X[0] = *(const u32x4*)(xp_); X[1] = *(const u32x4*)(xp_ + 32); } while (0)
#define RT_STEP(cc, X) do { const LAS unsigned char* bp_ = Bb + ((cc) & 1) * 20480 + r * 256; \
            bf16x8 bfr_[2][5]; \
            _Pragma("unroll") for (int u = 0; u < 2; ++u) { const int sl_ = ((((half * 2 + u) * 4 + g4) ^ r) << 4); \
                _Pragma("unroll") for (int nt = 0; nt < 5; ++nt) bfr_[u][nt] = *(const LAS bf16x8*)(bp_ + nt * 4096 + sl_); } \
            _Pragma("unroll") for (int u = 0; u < 2; ++u) { \
                const float a0 = bf_lo(X[u].x), a1 = bf_hi(X[u].x), a2 = bf_lo(X[u].y), a3 = bf_hi(X[u].y), a4 = bf_lo(X[u].z), a5 = bf_hi(X[u].z), a6 = bf_lo(X[u].w), a7 = bf_hi(X[u].w); \
                ss += ((a0 * a0 + a1 * a1) + (a2 * a2 + a3 * a3)) + ((a4 * a4 + a5 * a5) + (a6 * a6 + a7 * a7)); } \
            __builtin_amdgcn_sched_barrier(0); \
            _Pragma("unroll") for (int u = 0; u < 2; ++u) { const bf16x8 af = __builtin_bit_cast(bf16x8, X[u]); \
                _Pragma("unroll") for (int nt = 0; nt < 5; ++nt) acc[nt] = mfma16(af, bfr_[u][nt], acc[nt]); } \
            __builtin_amdgcn_sched_barrier(0); \
            if ((cc) + 4 < 32) RT_XLOAD(X, (cc) + 4); \
            if ((cc) + 1 < 32) { RT_BWRITE(((cc) + 1) & 1); if ((cc) + 2 < 32) RT_BLOAD((cc) + 2); } \
            LDS_BARRIER(); } while (0)
        __syncthreads();
        RT_BLOAD(0); RT_XLOAD(x0, 0); RT_XLOAD(x1, 1); RT_XLOAD(x2, 2); RT_XLOAD(x3, 3);
        RT_BWRITE(0); RT_BLOAD(1);
        LDS_BARRIER();
#pragma unroll 1
        for (int c0 = 0; c0 < 32; c0 += 4) { RT_STEP(c0, x0); RT_STEP(c0 + 1, x1); RT_STEP(c0 + 2, x2); RT_STEP(c0 + 3, x3); }
#undef RT_KC
#undef RT_BLOAD
#undef RT_BWRITE
#undef RT_XLOAD
#undef RT_STEP
        ss += __shfl_xor(ss, 16); ss += __shfl_xor(ss, 32);
#pragma unroll
        for (int nt = 0; nt < 5; ++nt)
#pragma unroll
            for (int rr = 0; rr < 4; ++rr) lg[(4 * g4 + rr) * 81 + 16 * nt + r] = acc[nt][rr];
        if (lane < 16) lg[16 * 81 + lane] = ss;
        __syncthreads();
        if (half == 0 && lane < 16) {
            const int token = row0 + lane; const LAS float* lr = lg + lane * 81; const LAS float* lr2 = lr + (16 * 81 + 16);
            const float rstd = 1.0f / sqrtf((lg[16 * 81 + lane] + lg[(16 * 81 + 16) + 16 * 81 + lane]) * (1.0f / DM) + EPS);
            float best = -3.0e38f; int gsel = 0; float glv[8];
#pragma unroll
            for (int j = 0; j < 8; ++j) { glv[j] = (lr[j] + lr2[j]) * rstd + F.rgb[j]; if (glv[j] > best) { best = glv[j]; gsel = j; } }
            float sum = 0.f;
#pragma unroll
            for (int j = 0; j < 8; ++j) sum += expf(glv[j] - best);
            const float gp = 1.0f / sum;
            float b1 = -3.0e38f, b2 = -3.0e38f; int i1 = 0, i2 = 0;
#pragma unroll
            for (int j = 0; j < 8; ++j) { const float v = (lr[8 + gsel * 8 + j] + lr2[8 + gsel * 8 + j]) * rstd + F.reb[gsel * 8 + j];
                if (v > b1) { b2 = b1; i2 = i1; b1 = v; i1 = j; } else if (v > b2) { b2 = v; i2 = j; } }
            const float e2 = expf(b2 - b1); const float w1 = gp / (1.0f + e2), w2 = gp * e2 / (1.0f + e2);
            F.RSTD2[token] = rstd;
            const int ex1 = gsel * 8 + i1, ex2 = gsel * 8 + i2;
            const unsigned p1 = atomicAdd(F.ctl + CW_CNT + 64 * ex1, 1u); F.LIST[ex1 * LISTCAP + p1] = token * 2; F.AW[token * 2] = w1; F.APOS[token * 2] = (ex1 << 16) | (int)p1;
            const unsigned p2 = atomicAdd(F.ctl + CW_CNT + 64 * ex2, 1u); F.LIST[ex2 * LISTCAP + p2] = token * 2 + 1; F.AW[token * 2 + 1] = w2; F.APOS[token * 2 + 1] = (ex2 << 16) | (int)p2;
        }
        __syncthreads();
    }
}

__device__ __forceinline__ void phase_final(Frame& F) {
    const int gw = F.vcu * 8 + F.wave, NGW = F.G * 8;
    const LAS int* tstart = (const LAS int*)(F.lds + TAB_OFF) + 64;
    u32x2 xa[16], pa[16], qa[16], xb[16], pb[16], qb[16]; float w0a, w1a, w0b, w1b;
#define FIN_LOAD(m, X, P, Q, W0, W1) do { const int ap0_ = F.APOS[2 * (m)], ap1_ = F.APOS[2 * (m) + 1]; W0 = F.AW[2 * (m)]; W1 = F.AW[2 * (m) + 1]; \
        const int row0_ = tstart[ap0_ >> 16] * 256 + (ap0_ & 0xffff), row1_ = tstart[ap1_ >> 16] * 256 + (ap1_ & 0xffff); \
        const u32x2* xr_ = (const u32x2*)(F.X1 + (size_t)(m) * DM) + F.lane; const u32x2* y0_ = (const u32x2*)(F.YT + (size_t)row0_ * DM) + F.lane; const u32x2* y1_ = (const u32x2*)(F.YT + (size_t)row1_ * DM) + F.lane; \
        _Pragma("unroll") for (int j = 0; j < 16; ++j) { X[j] = __builtin_nontemporal_load(xr_ + 64 * j); P[j] = __builtin_nontemporal_load(y0_ + 64 * j); Q[j] = __builtin_nontemporal_load(y1_ + 64 * j); } } while (0)
    int m = gw;
    if (m < NTOK) FIN_LOAD(m, xa, pa, qa, w0a, w1a);
    for (; m < NTOK; m += NGW) {
        const bool has = (m + NGW) < NTOK;
        if (has) FIN_LOAD(m + NGW, xb, pb, qb, w0b, w1b);
        f32x4* orow = (f32x4*)(F.out + (size_t)m * DM) + F.lane; const f32x4* gr = (const f32x4*)F.gf + F.lane;
        f32x4 v[16]; float ss = 0.f;
#pragma unroll
        for (int j = 0; j < 16; ++j) { const f32x4 a = (f32x4){bf_lo(xa[j].x), bf_hi(xa[j].x), bf_lo(xa[j].y), bf_hi(xa[j].y)};
            v[j].x = a.x + w0a * bf_lo(pa[j].x) + w1a * bf_lo(qa[j].x); v[j].y = a.y + w0a * bf_hi(pa[j].x) + w1a * bf_hi(qa[j].x); v[j].z = a.z + w0a * bf_lo(pa[j].y) + w1a * bf_lo(qa[j].y); v[j].w = a.w + w0a * bf_hi(pa[j].y) + w1a * bf_hi(qa[j].y);
            ss += (v[j].x * v[j].x + v[j].y * v[j].y) + (v[j].z * v[j].z + v[j].w * v[j].w); }
        ss = wave_sum(ss);
        const float rstd = 1.0f / sqrtf(ss * (1.0f / DM) + EPS);
#pragma unroll
        for (int j = 0; j < 16; ++j) __builtin_nontemporal_store(v[j] * rstd * gr[64 * j], orow + 64 * j);
        if (has) { w0a = w0b; w1a = w1b;
#pragma unroll
            for (int j = 0; j < 16; ++j) { xa[j] = xb[j]; pa[j] = pb[j]; qa[j] = qb[j]; } }
    }
#undef FIN_LOAD
}

__device__ __forceinline__ int moe_tables(Frame& F) {
    LAS int* cnts = (LAS int*)(F.lds + TAB_OFF); LAS int* tstart = cnts + 64; LAS int* tl = cnts + 144;
    __syncthreads();
    if (F.tid < 64) {
        const int e = F.tid, cnt = (int)F.ctl[CW_CNT + 64 * e]; cnts[e] = cnt;
        const int nt = (cnt + 255) >> 8, nsmall = (nt > 0 && cnt - 256 * (nt - 1) <= 128) ? 1 : 0, nbig = nt - nsmall;
        int pt = nt, pb = nbig, ps = nsmall;
#pragma unroll
        for (int o = 1; o < 64; o <<= 1) { const int a = __shfl_up(pt, o), b = __shfl_up(pb, o), c = __shfl_up(ps, o); if (e >= o) { pt += a; pb += b; ps += c; } }
        const int Tb = __shfl(pb, 63), T = __shfl(pt, 63);
        tstart[e] = pt - nt; if (e == 63) { tstart[64] = T; cnts[130] = Tb; }
        for (int t = 0; t < nbig; ++t) tl[pb - nbig + t] = (e << 8) | t;
        if (nsmall) tl[Tb + ps - 1] = (e << 8) | (nt - 1);
    }
    __syncthreads();
    return tstart[64];
}
__device__ __forceinline__ const float* in_ptr(LAS unsigned char* lds, int k) {
    const unsigned long long v = ((const LAS unsigned long long*)(lds + PTAB_OFF))[k];
    const unsigned lo = __builtin_amdgcn_readfirstlane((unsigned)v), hi = __builtin_amdgcn_readfirstlane((unsigned)(v >> 32));
    return (const float*)(const GAS float*)(((unsigned long long)hi << 32) | lo);
}
constexpr int N_PHASES = 10;
struct Args { const float* in[19]; float* out; unsigned char* ws; int ph_lo, ph_hi, li, pad; };
__global__ void __launch_bounds__(512, 2) fwd_kernel(Args args) {
    extern __shared__ __attribute__((aligned(16))) unsigned char lds_raw[];
    Frame F;
    F.lds = (LAS unsigned char*)lds_raw;
    volatile LAS unsigned* MISC = (volatile LAS unsigned*)(F.lds + MISC_OFF);
    F.tid = threadIdx.x; F.lane = F.tid & 63; F.wave = __builtin_amdgcn_readfirstlane(F.tid >> 6);
    F.G = gridDim.x; { const int bx = blockIdx.x; F.vcu = (F.G % 8 == 0) ? (bx % 8) * (F.G / 8) + bx / 8 : bx; }
    unsigned char* ws = args.ws;
    F.ctl = (unsigned*)(ws + WS_CTL);
    F.out = args.out;
    for (int u = F.tid; u < 128; u += 512) ((LAS unsigned*)(F.lds + MISC_OFF))[u] = 0u;
    __syncthreads();
    if (F.tid == 0) { LAS unsigned long long* pt = (LAS unsigned long long*)(F.lds + PTAB_OFF);
#pragma unroll
        for (int k = 0; k < 19; ++k) pt[k] = (unsigned long long)args.in[k]; }
    __syncthreads();
#define INP(k) in_ptr(F.lds, (k))
#define WSP(T, off) ((T*)(ws + (off)))
    XcdBarrier bar; bar.bar = F.ctl + CW_BAR; bar.x = 0; bar.st = nullptr;
    if (MK_N_LAUNCHES == 1) bar = xcd_barrier_post(F.ctl + CW_BAR, MISC + 8);
    const int lo = args.ph_lo, hi = args.ph_hi;
#ifndef PHASE_MASK
#define PHASE_MASK 0x3ff
#endif
#define IN(k) ((((PHASE_MASK) >> (k)) & 1) && lo <= (k) && (k) < hi)
#define RELANE() do { int l_ = (int)__builtin_amdgcn_mbcnt_hi(~0u, __builtin_amdgcn_mbcnt_lo(~0u, 0u)); asm volatile("" : "+v"(l_)); F.lane = l_; F.tid = F.wave * 64 + F.lane; } while (0)
#define SEAM(k) do { if (IN(k) && IN((k) + 1)) xcd_barrier(bar, F.wave == 0 && __builtin_amdgcn_mbcnt_hi(~0u, __builtin_amdgcn_mbcnt_lo(~0u, 0u)) == 0u); } while (0)
#ifndef REPS_MASK
#define REPS_MASK 0
#endif
#define NREP(k) ((((REPS_MASK) >> (k)) & 1) ? 2 : 1)

    if (IN(0)) { RELANE(); F.g2 = INP(10); F.x = INP(0); F.g1 = INP(1); F.w_in = INP(2); F.w_out = INP(9); F.rgw = INP(11); F.rew = INP(13); F.wg = INP(15); F.wu = INP(16); F.wd = INP(17);
        F.ACT = WSP(bf16_t, WS_ACT); F.GATES = WSP(float, WS_GATES); F.WIN_T = WSP(bf16_t, WS_WIN); F.WOUT_T = WSP(bf16_t, WS_WOUT); F.WGU_T = WSP(bf16_t, WS_WGU); F.WD_T = WSP(bf16_t, WS_WD); F.WRT = WSP(bf16_t, WS_WRT);
        for (int rep = 0; rep < NREP(0); ++rep) { phase0(F); RELANE(); phase0b(F); __syncthreads(); } } SEAM(0);
    if (IN(1)) { RELANE();
        if ((int)blockIdx.x < 16) { F.igb = INP(6); F.fgb = INP(7); F.GATES = WSP(float, WS_GATES); F.GS = WSP(float, WS_GS); for (int bh = (int)blockIdx.x; bh < 16; bh += F.G) phase_gates(F, bh); RELANE(); }
        if ((int)blockIdx.x < NCONV && F.G > 2 * NCONV) {
            F.g2 = INP(10); F.wg = INP(15); F.wu = INP(16); F.wd = INP(17); F.WGU_T = WSP(bf16_t, WS_WGU); F.WD_T = WSP(bf16_t, WS_WD); F.w_in = INP(2); F.w_out = INP(9); F.WIN_T = WSP(bf16_t, WS_WIN); F.WOUT_T = WSP(bf16_t, WS_WOUT);
            phase_convert(F, ITEMS_DENSE, NITEMS, (int)blockIdx.x * 8 + F.wave, -(NCONV * 8)); __syncthreads();
        } else if (F.G <= 2 * NCONV) {
            F.g2 = INP(10); F.wg = INP(15); F.wu = INP(16); F.wd = INP(17); F.WGU_T = WSP(bf16_t, WS_WGU); F.WD_T = WSP(bf16_t, WS_WD); F.w_in = INP(2); F.w_out = INP(9); F.WIN_T = WSP(bf16_t, WS_WIN); F.WOUT_T = WSP(bf16_t, WS_WOUT);
            phase_convert(F, ITEMS_DENSE, NITEMS, F.vcu * 8 + F.wave, F.G * 8); __syncthreads(); }
        { pg8::DynSched<4096> S; S.init(NTOK, NPROJ, WSP(bf16_t, WS_ACT), WSP(bf16_t, WS_WIN), F.ctl + CW_Q1, (volatile LAS int*)(F.lds + TAB_OFF), (int)xb_xcc_id()); S.t0 = (F.tid == 0); S.prime();
          pg8::EpiProj E{WSP(bf16_t, WS_PROJ), WSP(bf16_t, WS_QH), WSP(bf16_t, WS_KH), WSP(bf16_t, WS_VH), WSP(float, WS_VSSP)};
          pg8::gemm_phase<pg8::EpiProj, pg8::DynSched<4096>, 4096>(F.lds, S, E, F.wave, F.lane); }
        } SEAM(1);
    if (IN(2)) { RELANE(); F.gvn = INP(3); F.gsw = INP(4); F.gsb = INP(5); F.igb = INP(6); F.fgb = INP(7);
        F.PROJ = WSP(bf16_t, WS_PROJ); F.ACT = WSP(bf16_t, WS_ACT); F.GATES = WSP(float, WS_GATES); F.HB = WSP(float, WS_HB); F.QH = WSP(bf16_t, WS_QH); F.KH = WSP(bf16_t, WS_KH); F.VH = WSP(bf16_t, WS_VH); F.VSSP = WSP(float, WS_VSSP); F.GS = WSP(float, WS_GS);
#ifndef P2_SEL
#define P2_SEL 3
#endif
        F.PM = WSP(bf16_t, WS_PM); F.KP = WSP(bf16_t, WS_KP); phase_mlstm_pre(F);
        if (MK_N_LAUNCHES == 1) xcd_barrier(bar, F.wave == 0 && __builtin_amdgcn_mbcnt_hi(~0u, __builtin_amdgcn_mbcnt_lo(~0u, 0u)) == 0u);
        RELANE();
        for (int rep = 0; rep < NREP(9); ++rep) phase_mlstm(F); RELANE(); for (int rep = 0; rep < NREP(10); ++rep) phase_gmlp(F); } SEAM(2);
    if (IN(3)) { RELANE(); F.ogn = INP(8); F.PROJ = WSP(bf16_t, WS_PROJ); F.ACT = WSP(bf16_t, WS_ACT); F.HB = WSP(float, WS_HB); for (int rep = 0; rep < NREP(3); ++rep) phase_mlnorm(F); } SEAM(3);
    if (IN(4)) { RELANE(); pg8::DenseSched<4096> S; S.init(NTOK, DM, F.G, (int)blockIdx.x, WSP(bf16_t, WS_ACT), WSP(bf16_t, WS_WOUT)); pg8::EpiRes E{INP(0), WSP(bf16_t, WS_X1)};
        pg8::gemm_phase<pg8::EpiRes, pg8::DenseSched<4096>, 4096>(F.lds, S, E, F.wave, F.lane);
        if (NREP(4) == 2) { __syncthreads(); pg8::gemm_phase<pg8::EpiRes, pg8::DenseSched<4096>, 4096>(F.lds, S, E, F.wave, F.lane); } } SEAM(4);
    if (IN(5)) { RELANE(); F.g2 = INP(10); F.rgb = INP(12); F.reb = INP(14); F.ACT = WSP(bf16_t, WS_ACT); F.WRT = WSP(bf16_t, WS_WRT); F.RSTD2 = WSP(float, WS_RSTD2); F.AW = WSP(float, WS_AW); F.LIST = WSP(int, WS_LIST); F.APOS = WSP(int, WS_APOS); F.X1 = WSP(bf16_t, WS_X1);
        phase_router(F); } SEAM(5);
#define MOE_SCHED_INIT(S) do { S.cnts = (const LAS int*)(F.lds + TAB_OFF); S.tstart = S.cnts + 64; S.tl = S.cnts + 144; S.G = F.G; S.c = F.vcu; S.list = WSP(int, WS_LIST); S.ctr = nullptr; S.slot = nullptr; S.t0 = false; } while (0)
#define MOE_GU(S) do { S.A = (const char*)WSP(bf16_t, WS_X1); S.Bt = (const char*)WSP(bf16_t, WS_WGU); S.bexp = (size_t)1024 * DM * 2; } while (0)
#define MOE_DN(S) do { S.A = (const char*)WSP(bf16_t, WS_HM); S.Bt = (const char*)WSP(bf16_t, WS_WD); S.bexp = (size_t)DM * DEXP * 2; } while (0)
    if (IN(6)) { RELANE(); const int T = moe_tables(F); const int U6 = (T * 4 < ((2 * F.G) & ~3)) ? T * 4 : ((2 * F.G) & ~3);
        pg8::MoeSched<4096, 2, true> S; MOE_SCHED_INIT(S); MOE_GU(S); S.u_lo = 0; S.u_hi = U6;
        pg8::EpiGU E{WSP(bf16_t, WS_HM), WSP(int, WS_LIST), WSP(float, WS_RSTD2)};
        pg8::gemm_phase<pg8::EpiGU, pg8::MoeSched<4096, 2, true>, 4096, true>(F.lds, S, E, F.wave, F.lane); } SEAM(6);
    if (IN(7)) { RELANE(); const int T = ((const LAS int*)(F.lds + TAB_OFF))[128];     const int U6 = (T * 4 < ((2 * F.G) & ~3)) ? T * 4 : ((2 * F.G) & ~3); const int T6 = U6 >> 2;
        { pg8::MoeSched<4096, 2, true, true> S; MOE_SCHED_INIT(S); MOE_GU(S); S.u_lo = U6; S.u_hi = T * 4; S.ctr = F.ctl + CW_QA; S.slot = (volatile LAS int*)(F.lds + TAB_OFF + 1408); S.t0 = (F.tid == 0); S.prime();
          pg8::EpiGU E{WSP(bf16_t, WS_HM), WSP(int, WS_LIST), WSP(float, WS_RSTD2)};
          pg8::gemm_phase<pg8::EpiGU, pg8::MoeSched<4096, 2, true, true>, 4096, true>(F.lds, S, E, F.wave, F.lane); }
        __syncthreads(); RELANE();
        { pg8::MoeSched<512, 4, false, true> S; MOE_SCHED_INIT(S); MOE_DN(S); S.u_lo = 0; S.u_hi = T6 * 16; S.ctr = F.ctl + CW_QB; S.slot = (volatile LAS int*)(F.lds + TAB_OFF + 1440); S.t0 = (F.tid == 0); S.prime();
          pg8::EpiDown E{WSP(bf16_t, WS_YT)};
          pg8::gemm_phase<pg8::EpiDown, pg8::MoeSched<512, 4, false, true>, 512, true>(F.lds, S, E, F.wave, F.lane); } } SEAM(7);
    if (IN(8)) { RELANE(); const int T = ((const LAS int*)(F.lds + TAB_OFF))[128]; const int U6 = (T * 4 < ((2 * F.G) & ~3)) ? T * 4 : ((2 * F.G) & ~3); const int T6 = U6 >> 2;
        pg8::MoeSched<512, 4, false> S; MOE_SCHED_INIT(S); MOE_DN(S); S.u_lo = T6 * 16; S.u_hi = T * 16;
        pg8::EpiDown E{WSP(bf16_t, WS_YT)};
        pg8::gemm_phase<pg8::EpiDown, pg8::MoeSched<512, 4, false>, 512, true>(F.lds, S, E, F.wave, F.lane); } SEAM(8);
    if (IN(9)) { RELANE(); F.gf = INP(18); F.YT = WSP(bf16_t, WS_YT); F.AW = WSP(float, WS_AW); F.APOS = WSP(int, WS_APOS); F.X1 = WSP(bf16_t, WS_X1);
        phase_final(F); }
#undef IN
#undef SEAM
}

extern "C" void kernel_launch(void* const* d_in, const int* in_sizes, int n_in, void* d_out, int out_size, void* d_ws, size_t ws_size, hipStream_t stream) {
    static int grid = 0;
    if (grid == 0) {
        if (n_in != 19 || out_size != NTOK * DM || ws_size < WS_END) { fprintf(stderr, "kernel_launch: unexpected shapes (n_in %d, out %d, ws %zu)\n", n_in, out_size, ws_size); grid = -1; return; }
        int dev = 0, cus = 0, per_cu = 0;
        if (hipGetDevice(&dev) != hipSuccess || hipDeviceGetAttribute(&cus, hipDeviceAttributeMultiprocessorCount, dev) != hipSuccess) { grid = -1; return; }
        if (hipFuncSetAttribute((const void*)fwd_kernel, hipFuncAttributeMaxDynamicSharedMemorySize, LDS_BYTES) != hipSuccess) { fprintf(stderr, "kernel_launch: hipFuncSetAttribute failed\n"); grid = -1; return; }
        if (hipOccupancyMaxActiveBlocksPerMultiprocessor(&per_cu, (const void*)fwd_kernel, 512, LDS_BYTES) != hipSuccess || per_cu < 1) fprintf(stderr, "kernel_launch: occupancy query reports %d\n", per_cu);
        (void)hipGetLastError();
        grid = cus;
    }
    if (grid < 0) return;
    if (hipMemsetAsync((char*)d_ws + WS_CTL, 0, CTL_ZERO_BYTES, stream) != hipSuccess) return;
    Args a{};
    for (int i = 0; i < 19; ++i) a.in[i] = (const float*)d_in[i];
    a.out = (float*)d_out; a.ws = (unsigned char*)d_ws; a.pad = 0;
    if (MK_N_LAUNCHES == 1) { a.ph_lo = 0; a.ph_hi = N_PHASES; a.li = 0; hipLaunchKernelGGL(fwd_kernel, dim3(grid), dim3(512), LDS_BYTES, stream, a); }
    else for (int li = 0; li < N_PHASES; ++li) { a.ph_lo = li; a.ph_hi = li + 1; a.li = li; hipLaunchKernelGGL(fwd_kernel, dim3(grid), dim3(512), LDS_BYTES, stream, a); }
}
```

```cpp
#include <hip/hip_runtime.h>
#include <cstdio>
#include <cstdint>

#ifndef MK_N_LAUNCHES
#define MK_N_LAUNCHES 1
#endif

#ifndef PROBE0
#define PROBE0 1
#endif
#define LAS __attribute__((address_space(3)))
#define GAS __attribute__((address_space(1)))
typedef unsigned short bf16_t;
typedef short bf16x8 __attribute__((ext_vector_type(8)));
typedef float f32x4 __attribute__((ext_vector_type(4)));
typedef float f32x2 __attribute__((ext_vector_type(2)));
typedef unsigned u32x4 __attribute__((ext_vector_type(4)));
typedef unsigned u32x2 __attribute__((ext_vector_type(2)));

constexpr int DM = 4096, NTOK = 16384, SEQL = 4096;
constexpr int NPROJ = 10240, LDW_IN = 10248;
constexpr int C_U = 0, C_V = 2048, C_Q = 4096, C_K = 5120, C_VB = 6144, C_O = 8192;
constexpr int NEXP = 64, DEXP = 512, LISTCAP = 16384;
constexpr float EPS = 1e-6f;

constexpr size_t MiB = 1u << 20;
constexpr size_t WS_CTL = 0, CTL_ZERO_BYTES = 1 * MiB;
constexpr size_t WS_GATES = 1 * MiB;
constexpr size_t WS_RSTD2 = 1 * MiB + 512 * 1024;
constexpr size_t WS_AW = WS_RSTD2 + 64 * 1024;
constexpr size_t WS_APOS = WS_AW + 128 * 1024;
constexpr size_t WS_WRT = 2 * MiB;
constexpr size_t WS_LIST = 3 * MiB;
constexpr size_t WS_GS = 7 * MiB;
constexpr size_t WS_WIN = 8 * MiB;
constexpr size_t WS_WOUT = 88 * MiB;
constexpr size_t WS_WGU = 120 * MiB;
constexpr size_t WS_WD = 632 * MiB;
constexpr size_t WS_ACT = 888 * MiB;
constexpr size_t WS_PROJ = 1016 * MiB;
constexpr size_t WS_YT = WS_PROJ;
constexpr size_t WS_HM = 1464 * MiB;
constexpr size_t WS_PM = WS_HM;
constexpr size_t WS_KP = WS_HM + 16 * MiB;
constexpr size_t WS_HB = 1336 * MiB;
constexpr size_t WS_QH = 1512 * MiB;
constexpr size_t WS_KH = 1544 * MiB;
constexpr size_t WS_VH = 1576 * MiB;
constexpr size_t WS_X1 = 1640 * MiB;
constexpr size_t WS_VSSP = 1768 * MiB;
constexpr size_t WS_END = 1770 * MiB;
constexpr int CW_BAR = 4096;
constexpr int CW_CNT = 16384;
constexpr int CW_QA = 26624, CW_QB = 26688;
constexpr int CW_Q1 = 24576;

constexpr int LDS_BYTES = 147456;
constexpr int TAB_OFF = 131072;
constexpr int MISC_OFF = LDS_BYTES - 512;
constexpr int PTAB_OFF = MISC_OFF + 256;

__device__ __forceinline__ unsigned f2bf(float f) { unsigned u = __builtin_bit_cast(unsigned, f); return (u + 0x7fffu + ((u >> 16) & 1u)) >> 16; }
__device__ __forceinline__ float bf2f(unsigned b) { return __builtin_bit_cast(float, b << 16); }
__device__ __forceinline__ unsigned pk2(float lo, float hi) { return f2bf(lo) | (f2bf(hi) << 16); }
__device__ __forceinline__ float bf_lo(unsigned w) { return __builtin_bit_cast(float, w << 16); }
__device__ __forceinline__ float bf_hi(unsigned w) { return __builtin_bit_cast(float, w & 0xffff0000u); }
__device__ __forceinline__ float wave_sum(float v) {
#pragma unroll
    for (int o = 1; o < 64; o <<= 1) v += __shfl_xor(v, o);
    return v;
}
__device__ __forceinline__ float fast_exp(float x) { return __builtin_amdgcn_exp2f(x * 1.4426950408889634f); }
__device__ __forceinline__ float gelu_tanh(float x) {
    const float t = x * (1.0f + 0.044715f * x * x) * 1.5957691216057308f;
    return x * __builtin_amdgcn_rcpf(1.0f + fast_exp(-t));
}
__device__ __forceinline__ float sigmoid_f(float x) { return __builtin_amdgcn_rcpf(1.0f + fast_exp(-x)); }
__device__ __forceinline__ unsigned cvtpk(float lo, float hi) { unsigned r; asm volatile("v_cvt_pk_bf16_f32 %0, %1, %2" : "=v"(r) : "v"(lo), "v"(hi)); return r; }
#define LDS_WAIT() asm volatile("s_waitcnt lgkmcnt(0)" ::: "memory")
#define VM_WAIT() asm volatile("s_waitcnt vmcnt(0)" ::: "memory")
#define LDS_BARRIER() do { asm volatile("s_waitcnt lgkmcnt(0)" ::: "memory"); __builtin_amdgcn_s_barrier(); asm volatile("" ::: "memory"); } while (0)
__device__ __forceinline__ f32x4 mfma16(bf16x8 a, bf16x8 b, f32x4 c) { return __builtin_amdgcn_mfma_f32_16x16x32_bf16(a, b, c, 0, 0, 0); }

namespace pg8 {
constexpr int BM = 256, BK = 64, HALF = 128, HTB = HALF * BK * 2, STAGE_BYTES = 8 * HTB, NXCD = 8, WGM = 8;
__host__ __device__ __forceinline__ int lds_byte(int r, int c) { const int st = (r >> 4) * 2 + (c >> 5), rr = r & 15, cc = c & 31, ob = rr * 64 + cc * 2; return st * 1024 + (ob ^ (((ob >> 9) & 1) << 5)); }
__host__ __device__ __forceinline__ void stage_rc(int b, int& R, int& C) { const int st = b / 1024, sb = b % 1024, swz = sb ^ (((sb >> 9) & 1) << 5); R = (st >> 1) * 16 + swz / 64; C = (st & 1) * 32 + (swz % 64) / 2; }
__host__ __device__ __forceinline__ int perm32(int rho) { const int n = rho >> 4, i = rho & 15; return 8 * (i >> 2) + 4 * n + (i & 3); }

struct Unit { int pm, pn, e, nvalid, rowbase; };

template <int K> struct DenseSched {
    int nM, nN, nwg, G, c; const char* A; const char* Bt;
    __device__ void init(int M, int N, int G_, int c_, const void* A_, const void* Bt_) { nM = M / BM; nN = N / BM; nwg = nM * nN; G = G_; c = c_; A = (const char*)A_; Bt = (const char*)Bt_; }
    __device__ __forceinline__ bool next(int i, Unit& u) const {
        const long L = (long)i * G + c; if (L >= nwg) return false;
        int wgid = (int)L; { const int q = nwg / NXCD, r = nwg % NXCD, xcd = wgid % NXCD, off = wgid / NXCD; wgid = (xcd < r ? xcd * (q + 1) : r * (q + 1) + (xcd - r) * q) + off; }
        const int nig = WGM * nN, gid = wgid / nig, fm = gid * WGM, gsz = (nM - fm) < WGM ? (nM - fm) : WGM;
        u.pm = fm + ((wgid % nig) % gsz); u.pn = (wgid % nig) / gsz; u.e = 0; u.nvalid = 256; u.rowbase = u.pm * 256; return true;
    }
    __device__ __forceinline__ const char* a_base() const { return A; }
    __device__ __forceinline__ unsigned a_off(const Unit& u, int row) const { return (unsigned)(u.pm * 256 + row) * (unsigned)(K * 2); }
    __device__ __forceinline__ const char* b_ptr(const Unit& u) const { return Bt + (size_t)u.pn * 256 * K * 2; }
};
template <int K> struct DynSched {
    int nM, nN, nwg, xcc; const char* A; const char* Bt; unsigned* ctr; volatile LAS int* slot; bool t0;
    __device__ void init(int M, int N, const void* A_, const void* Bt_, unsigned* ctr_, volatile LAS int* slot_, int xcc_) { nM = M / BM; nN = N / BM; nwg = nM * nN; A = (const char*)A_; Bt = (const char*)Bt_; ctr = ctr_; slot = slot_; xcc = xcc_ & 7; }
    __device__ __forceinline__ int draw() const {
        const int per = nwg / NXCD;
        for (int a = 0; a < NXCD; ++a) { const int x = (xcc + a) & 7; const int n = (int)__hip_atomic_fetch_add(ctr + 64 * x, 1u, __ATOMIC_RELAXED, __HIP_MEMORY_SCOPE_AGENT); if (n < per) return NXCD * n + x; }
        return nwg;
    }
    __device__ __forceinline__ void prime() const {
        if (t0) { slot[0] = draw(); slot[1] = draw(); }
        __syncthreads();
    }
    __device__ __forceinline__ bool next(int i, Unit& u) const {
        const int L = __builtin_amdgcn_readfirstlane(slot[i & 3]);
        if (i >= 1 && t0) slot[(i + 1) & 3] = (L < nwg) ? draw() : nwg;
        if (L >= nwg) return false;
        int wgid = L; { const int q = nwg / NXCD, r = nwg % NXCD, xcd = wgid % NXCD, off = wgid / NXCD; wgid = (xcd < r ? xcd * (q + 1) : r * (q + 1) + (xcd - r) * q) + off; }
        const int nig = WGM * nN, gid = wgid / nig, fm = gid * WGM, gsz = (nM - fm) < WGM ? (nM - fm) : WGM;
        u.pm = fm + ((wgid % nig) % gsz); u.pn = (wgid % nig) / gsz; u.e = 0; u.nvalid = 256; u.rowbase = u.pm * 256; return true;
    }
    __device__ __forceinline__ const char* a_base() const { return A; }
    __device__ __forceinline__ unsigned a_off(const Unit& u, int row) const { return (unsigned)(u.pm * 256 + row) * (unsigned)(K * 2); }
    __device__ __forceinline__ const char* b_ptr(const Unit& u) const { return Bt + (size_t)u.pn * 256 * K * 2; }
};
template <int K, int NPN_SHIFT, bool GATHER, bool DYN = false> struct MoeSched {
    const LAS int* cnts; const LAS int* tstart; const LAS int* tl; int u_lo, u_hi, G, c; const int* list; const char* A; const char* Bt; size_t bexp;
    unsigned* ctr; volatile LAS int* slot; bool t0;
    __device__ __forceinline__ int draw() const { return (int)__hip_atomic_fetch_add(ctr, 1u, __ATOMIC_RELAXED, __HIP_MEMORY_SCOPE_AGENT); }
    __device__ __forceinline__ void prime() const { if (t0) { slot[0] = draw(); slot[1] = draw(); } __syncthreads(); }
    __device__ __forceinline__ bool next(int i, Unit& u) const {
        int L;
        if (DYN) { const int n = __builtin_amdgcn_readfirstlane(slot[i & 3]); const int cntu = u_hi - u_lo;
            if (i >= 1 && t0) slot[(i + 1) & 3] = (n < cntu) ? draw() : cntu;
            if (n >= cntu) return false; L = u_lo + n; }
        else { L = u_lo + i * G + c; if (L >= u_hi) return false; }
        const int pk = __builtin_amdgcn_readfirstlane(tl[L >> NPN_SHIFT]); const int e = pk >> 8;
        u.pn = L & ((1 << NPN_SHIFT) - 1); u.e = e; u.pm = pk & 255;
        int nv = cnts[e] - u.pm * 256; nv = nv > 256 ? 256 : nv; u.nvalid = __builtin_amdgcn_readfirstlane(nv); u.rowbase = __builtin_amdgcn_readfirstlane((tstart[e] + u.pm) * 256); return true;
    }
    __device__ __forceinline__ const char* a_base() const { return A; }
    __device__ __forceinline__ unsigned a_off(const Unit& u, int row) const {
        if (GATHER) { int tok = 0; if (row < u.nvalid) tok = list[u.e * LISTCAP + u.pm * 256 + row] >> 1; return (unsigned)tok * (unsigned)(K * 2); }
        else return (unsigned)(u.rowbase + row) * (unsigned)(K * 2);
    }
    __device__ __forceinline__ const char* b_ptr(const Unit& u) const { return Bt + (size_t)u.e * bexp + (size_t)u.pn * 256 * K * 2; }
};

__device__ __forceinline__ unsigned cvt_pk_bf16(float lo, float hi) { unsigned r; asm volatile("v_cvt_pk_bf16_f32 %0, %1, %2" : "=v"(r) : "v"(lo), "v"(hi)); return r; }

template <class Epi, class Sched, int K, bool SKIP = false>
__device__ __forceinline__ void gemm_phase(LAS unsigned char* lds, const Sched& S, const Epi& E, const int wid, const int lane) {
    const int tid = wid * 64 + lane, wr = wid >> 2, wc = wid & 3, fr = lane & 15, fq = lane >> 4;
    constexpr int nt = K / BK;
    unsigned voffB[2]; int RA[2]; unsigned CA2[2];
#pragma unroll
    for (int i = 0; i < 2; ++i) { int R, C; stage_rc(tid * 16 + i * 8192, R, C); const int Rb = Epi::PERM ? ((R & ~31) + perm32(R & 31)) : R;
        RA[i] = R; CA2[i] = (unsigned)C * 2u; voffB[i] = (unsigned)(Rb * K + C) * 2u; }
    constexpr size_t kstep = (size_t)(BK * 2);
    constexpr size_t hstep = (size_t)HALF * K * 2;
    const unsigned ldsw = (unsigned)wid * 1024u;
    const int aoffl = lds_byte(wr * 64 + fr, fq * 8), boffl = lds_byte(wc * 32 + fr, fq * 8);
#define PG8_SA(b, h) (((b) * 2 + (h)) * HTB)
#define PG8_SB(b, h) ((4 + (b) * 2 + (h)) * HTB)
#define PG8_STAGE(bufoff, gbase, voff) do { _Pragma("unroll") for (int _i = 0; _i < 2; ++_i) \
        __builtin_amdgcn_global_load_lds((const unsigned*)((const char*)(gbase) + (voff)[_i]), (LAS unsigned*)(lds + (bufoff) + ldsw + _i * 8192), 16, 0, 0); } while (0)
#define PG8_LDA(dst, b, h) do { _Pragma("unroll") for (int m = 0; m < 4; ++m) _Pragma("unroll") for (int k = 0; k < 2; ++k) dst[m][k] = *(const LAS bf16x8*)(lds + PG8_SA(b, h) + aoffl + m * 2048 + k * 1024); } while (0)
#define PG8_LDB(dst, b, h) do { _Pragma("unroll") for (int n = 0; n < 2; ++n) _Pragma("unroll") for (int k = 0; k < 2; ++k) dst[n][k] = *(const LAS bf16x8*)(lds + PG8_SB(b, h) + boffl + n * 2048 + k * 1024); } while (0)
#define PG8_MMA(ai, bj, At, Bt) do { if (SKIP && !((ai) ? doA1 : doA0)) break; __builtin_amdgcn_s_setprio(1); _Pragma("unroll") for (int m = 0; m < 4; ++m) _Pragma("unroll") for (int n = 0; n < 2; ++n) _Pragma("unroll") for (int k = 0; k < 2; ++k) \
        acc[ai][bj][m][n] = __builtin_amdgcn_mfma_f32_16x16x32_bf16(Bt[n][k], At[m][k], acc[ai][bj][m][n], 0, 0, 0); __builtin_amdgcn_s_setprio(0); } while (0)
#define PG8_WAIT_V(n) asm volatile("s_waitcnt vmcnt(" #n ")" ::: "memory")
#define PG8_WAIT_L(n) asm volatile("s_waitcnt lgkmcnt(" #n ")" ::: "memory")
#define PG8_BAR __builtin_amdgcn_s_barrier()
#define PG8_SCHED __builtin_amdgcn_sched_barrier(0)
#define PG8_LOAD_AOFF(u) do { _Pragma("unroll") for (int _h = 0; _h < 2; ++_h) _Pragma("unroll") for (int _i = 0; _i < 2; ++_i) aoff[_h][_i] = S.a_off(u, _h * HALF + RA[_i]) + CA2[_i]; } while (0)
    Unit cur, nxt; int ui = 0;
    if (!S.next(0, cur)) return;
    f32x4 acc[2][2][4][2];
#pragma unroll
    for (int a = 0; a < 2; ++a)
#pragma unroll
        for (int b = 0; b < 2; ++b)
#pragma unroll
            for (int m = 0; m < 4; ++m)
#pragma unroll
                for (int n = 0; n < 2; ++n) acc[a][b][m][n] = (f32x4){0.f, 0.f, 0.f, 0.f};
    bf16x8 At[4][2], B0[2][2], B1[2][2];
    unsigned aoff[2][2];
    const char* const Ab = S.a_base();
    const char* cB = S.b_ptr(cur);
    PG8_LOAD_AOFF(cur);
    PG8_STAGE(PG8_SB(0, 0), cB, voffB); PG8_STAGE(PG8_SB(0, 1), cB + hstep, voffB); PG8_STAGE(PG8_SA(0, 0), Ab, aoff[0]); PG8_STAGE(PG8_SA(0, 1), Ab, aoff[1]);
    if (wr == 1) PG8_BAR;
    PG8_WAIT_V(2); PG8_BAR;
    PG8_STAGE(PG8_SB(1, 0), cB + kstep, voffB); PG8_STAGE(PG8_SA(1, 0), Ab + kstep, aoff[0]); PG8_STAGE(PG8_SB(1, 1), cB + hstep + kstep, voffB);
    PG8_WAIT_V(6); PG8_BAR;
    for (;;) {
        const bool has_next = S.next(ui + 1, nxt);
        const bool doA1 = cur.nvalid > 128, doA0 = (wr == 0) || (cur.nvalid > 64);
        const char* nB = has_next ? S.b_ptr(nxt) : cB;
        const char* pA = Ab;
        for (int t = 0; t < nt; t += 2) {
            const bool last = (t == nt - 2);
            const char* b2 = last ? nB : cB + (size_t)(t + 2) * kstep;
            const char* b3 = b2 + kstep;
            PG8_LDB(B0, 0, 0); PG8_LDB(B1, 0, 1); PG8_SCHED; if (!SKIP || doA0) PG8_LDA(At, 0, 0); PG8_STAGE(PG8_SA(1, 1), pA + (size_t)(t + 1) * kstep, aoff[1]);
            if (last) {
                if (has_next) { PG8_LOAD_AOFF(nxt); }
                pA = Ab - (size_t)(t + 2) * kstep;
            }
            PG8_WAIT_V(8); PG8_WAIT_L(0); PG8_BAR; PG8_MMA(0, 0, At, B0); PG8_MMA(0, 1, At, B1); PG8_BAR; PG8_SCHED;
            if (!SKIP || doA1) PG8_LDA(At, 0, 1); PG8_STAGE(PG8_SB(0, 0), b2, voffB); PG8_STAGE(PG8_SB(0, 1), b2 + hstep, voffB); PG8_STAGE(PG8_SA(0, 0), pA + (size_t)(t + 2) * kstep, aoff[0]);
            PG8_WAIT_V(8); PG8_WAIT_L(0); PG8_BAR; PG8_MMA(1, 0, At, B0); PG8_MMA(1, 1, At, B1); PG8_BAR; PG8_SCHED;
            PG8_LDB(B0, 1, 0); PG8_LDB(B1, 1, 1); PG8_SCHED; if (!SKIP || doA0) PG8_LDA(At, 1, 0); PG8_STAGE(PG8_SA(0, 1), pA + (size_t)(t + 2) * kstep, aoff[1]);
            PG8_WAIT_V(8); PG8_WAIT_L(0); PG8_BAR; PG8_MMA(0, 0, At, B0); PG8_MMA(0, 1, At, B1); PG8_BAR; PG8_SCHED;
            if (!SKIP || doA1) PG8_LDA(At, 1, 1); PG8_STAGE(PG8_SB(1, 0), b3, voffB); PG8_STAGE(PG8_SB(1, 1), b3 + hstep, voffB); PG8_STAGE(PG8_SA(1, 0), pA + (size_t)(t + 3) * kstep, aoff[0]);
            PG8_WAIT_V(8); PG8_WAIT_L(0); PG8_BAR; PG8_MMA(1, 0, At, B0); PG8_MMA(1, 1, At, B1); PG8_BAR; PG8_SCHED;
        }
        if (wr == 0) PG8_BAR;
        E(acc, cur, wr, wc, fr, fq);
        if (!has_next) break;
#pragma unroll
        for (int a = 0; a < 2; ++a)
#pragma unroll
            for (int b = 0; b < 2; ++b)
#pragma unroll
                for (int m = 0; m < 4; ++m)
#pragma unroll
                    for (int n = 0; n < 2; ++n) acc[a][b][m][n] = (f32x4){0.f, 0.f, 0.f, 0.f};
        cur = nxt; cB = nB; ++ui;
        if (wr == 1) PG8_BAR;
    }
    PG8_WAIT_V(0);
    PG8_BAR;
#undef PG8_SA
#undef PG8_SB
#undef PG8_STAGE
#undef PG8_LDA
#undef PG8_LDB
#undef PG8_MMA
#undef PG8_WAIT_V
#undef PG8_WAIT_L
#undef PG8_BAR
#undef PG8_SCHED
#undef PG8_LOAD_AOFF
}

struct EpiProj {
    static constexpr bool PERM = true;
    bf16_t* O; bf16_t* QH; bf16_t* KH; bf16_t* VH; float* VSSP;
    __device__ __forceinline__ void operator()(const f32x4 (&acc)[2][2][4][2], const Unit& u, int wr, int wc, int fr, int fq) const {
        const int act = (u.pn < 16) ? 1 : ((u.pn >= 32) ? 2 : 0);
        const float sc = (u.pn >= 20 && u.pn < 24) ? 0.0625f : 1.0f;
        const int row0 = u.pm * BM + wr * 64 + fr;
        bf16_t* base = O + (size_t)u.pn * BM; size_t pitch = NPROJ; size_t hoff = 0;
        if (u.pn >= 16 && u.pn < 24) { const int hh = (u.pn - 16) & 3; base = (u.pn < 20) ? QH : KH; pitch = 256; hoff = (size_t)hh * SEQL * 256; }
        else if (u.pn >= 24 && u.pn < 32) { const int hh = (u.pn - 24) >> 1; base = VH + ((u.pn - 24) & 1) * 256; pitch = 512; hoff = (size_t)hh * SEQL * 512; }
        const int col0 = wc * 32 + 8 * fq; const bool headmajor = (u.pn >= 16 && u.pn < 32);
#pragma unroll
        for (int ai = 0; ai < 2; ++ai)
#pragma unroll
            for (int m = 0; m < 4; ++m) { const int row = row0 + ai * HALF + m * 16;
                bf16_t* rowp = headmajor ? base + (size_t)(row >> 12) * 4 * SEQL * pitch + hoff + (size_t)(row & (SEQL - 1)) * pitch + col0 : base + (size_t)row * pitch + col0;
                float vss = 0.f;
#pragma unroll
                for (int bj = 0; bj < 2; ++bj) { f32x4 v0 = acc[ai][bj][m][0], v1 = acc[ai][bj][m][1];
                    if (act == 1) {
#pragma unroll
                        for (int j = 0; j < 4; ++j) { v0[j] = gelu_tanh(v0[j]); v1[j] = gelu_tanh(v1[j]); vss += v0[j] * v0[j] + v1[j] * v1[j]; } }
                    else if (act == 2) {
#pragma unroll
                        for (int j = 0; j < 4; ++j) { v0[j] = sigmoid_f(v0[j]); v1[j] = sigmoid_f(v1[j]); } }
                    else { v0 = v0 * sc; v1 = v1 * sc; }
                    u32x4 w; w.x = cvt_pk_bf16(v0[0], v0[1]); w.y = cvt_pk_bf16(v0[2], v0[3]); w.z = cvt_pk_bf16(v1[0], v1[1]); w.w = cvt_pk_bf16(v1[2], v1[3]);
                    *(u32x4*)(rowp + bj * HALF) = w; }
                if (u.pn >= 8 && u.pn < 16) { vss += __shfl_xor(vss, 16); vss += __shfl_xor(vss, 32);
                    if (fq == 0) VSSP[(size_t)row * 32 + (u.pn - 8) * 4 + wc] = vss; } }
    }
};
struct EpiRes {
    static constexpr bool PERM = true;
    const float* base; bf16_t* out;
    __device__ __forceinline__ void operator()(const f32x4 (&acc)[2][2][4][2], const Unit& u, int wr, int wc, int fr, int fq) const {
        const int row0 = u.pm * BM + wr * 64 + fr, col0 = u.pn * BM + wc * 32 + 8 * fq;
#pragma unroll
        for (int ai = 0; ai < 2; ++ai)
#pragma unroll
            for (int m = 0; m < 4; ++m) { const size_t off = (size_t)(row0 + ai * HALF + m * 16) * DM + col0;
#pragma unroll
                for (int bj = 0; bj < 2; ++bj) { const f32x4 b0 = *(const f32x4*)(base + off + bj * HALF), b1 = *(const f32x4*)(base + off + bj * HALF + 4);
                    const f32x4 v0 = b0 + acc[ai][bj][m][0], v1 = b1 + acc[ai][bj][m][1];
                    u32x4 w; w.x = cvt_pk_bf16(v0[0], v0[1]); w.y = cvt_pk_bf16(v0[2], v0[3]); w.z = cvt_pk_bf16(v1[0], v1[1]); w.w = cvt_pk_bf16(v1[2], v1[3]);
                    *(u32x4*)(out + off + bj * HALF) = w; } }
    }
};
struct EpiGU {
    static constexpr bool PERM = true;
    bf16_t* HM; const int* list; const float* rstd2;
    __device__ __forceinline__ void operator()(const f32x4 (&acc)[2][2][4][2], const Unit& u, int wr, int wc, int fr, int fq) const {
        const int col0 = u.pn * 128 + wc * 32 + 8 * fq;
#pragma unroll
        for (int ai = 0; ai < 2; ++ai)
#pragma unroll
            for (int m = 0; m < 4; ++m) { const int rt = ai * HALF + wr * 64 + m * 16 + fr;
                if (rt < u.nvalid) {
                    const int a = list[u.e * LISTCAP + u.pm * 256 + rt]; const float rs = rstd2[a >> 1];
                    float h[8];
#pragma unroll
                    for (int n = 0; n < 2; ++n)
#pragma unroll
                        for (int j = 0; j < 4; ++j) { const float g = acc[ai][0][m][n][j] * rs, up = acc[ai][1][m][n][j] * rs; h[n * 4 + j] = g * sigmoid_f(g) * up; }
                    u32x4 w; w.x = cvt_pk_bf16(h[0], h[1]); w.y = cvt_pk_bf16(h[2], h[3]); w.z = cvt_pk_bf16(h[4], h[5]); w.w = cvt_pk_bf16(h[6], h[7]);
                    *(u32x4*)(HM + (size_t)(u.rowbase + rt) * DEXP + col0) = w; } }
    }
};
struct EpiDown {
    static constexpr bool PERM = true;
    bf16_t* YT;
    __device__ __forceinline__ void operator()(const f32x4 (&acc)[2][2][4][2], const Unit& u, int wr, int wc, int fr, int fq) const {
        const int col0 = u.pn * BM + wc * 32 + 8 * fq;
#pragma unroll
        for (int ai = 0; ai < 2; ++ai)
#pragma unroll
            for (int m = 0; m < 4; ++m) { const int rt = ai * HALF + wr * 64 + m * 16 + fr; bf16_t* rowp = YT + (size_t)(u.rowbase + rt) * DM + col0;
                if (rt < u.nvalid) {
#pragma unroll
                for (int bj = 0; bj < 2; ++bj) { const f32x4 v0 = acc[ai][bj][m][0], v1 = acc[ai][bj][m][1];
                    u32x4 w; w.x = cvt_pk_bf16(v0[0], v0[1]); w.y = cvt_pk_bf16(v0[2], v0[3]); w.z = cvt_pk_bf16(v1[0], v1[1]); w.w = cvt_pk_bf16(v1[2], v1[3]);
                    *(u32x4*)(rowp + bj * HALF) = w; } } }
    }
};
}

#define XB_TMO      128
#define XB_XCNT(j)  (256  + 64 * (j))
#define XB_XSUB(j)  (1280 + 64 * (j))
#define XB_XGEN(j)  (2304 + 64 * (j))
#define XB_TOP      3328
#define XB_TOPGEN   3392
#define XCD_BAR_WORDS 3456
#define XB_SPIN_CAP (1u << 18)
__device__ __forceinline__ unsigned xb_ld(unsigned* p)              { return __hip_atomic_load(p, __ATOMIC_RELAXED, __HIP_MEMORY_SCOPE_AGENT); }
__device__ __forceinline__ unsigned xb_add(unsigned* p, unsigned v) { return __hip_atomic_fetch_add(p, v, __ATOMIC_RELAXED, __HIP_MEMORY_SCOPE_AGENT); }
__device__ __forceinline__ unsigned xb_xcc_id() { return (unsigned)__builtin_amdgcn_s_getreg((3 << 11) | 20) & 0xFu; }
#define XB_SPIN(cond, bar) do { unsigned _sp = 0; while (cond) { __builtin_amdgcn_s_sleep(1); \
    if ((++_sp & 255u) == 0u) { if (xb_ld(&(bar)[XB_TMO])) break; if (_sp > XB_SPIN_CAP) { atomicAdd(&(bar)[XB_TMO], 1u); break; } } } } while (0)
struct XcdBarrier { unsigned* bar; unsigned x; volatile LAS unsigned* st; };
__device__ __forceinline__ XcdBarrier xcd_barrier_post(unsigned* bar, volatile LAS unsigned* st) {
    XcdBarrier b; b.bar = bar; b.x = xb_xcc_id(); b.st = st;
    if (threadIdx.x == 0) (void)xb_add(&bar[XB_XCNT(b.x)], 1u);
    return b;
}
__device__ __forceinline__ void xcd_barrier_complete(unsigned* bar, unsigned x, unsigned& nloc, unsigned& nx) {
    const unsigned G = gridDim.x * gridDim.y * gridDim.z;
    unsigned sum, cnt, mine, sp = 0u;
    for (;;) {
        sum = 0u; cnt = 0u; mine = 0u;
#pragma unroll
        for (unsigned j = 0; j < 16; ++j) { const unsigned c = xb_ld(&bar[XB_XCNT(j)]); sum += c; cnt += (c > 0u) ? 1u : 0u; mine = (j == x) ? c : mine; }
        if (sum == G) break;
        __builtin_amdgcn_s_sleep(1);
        if ((++sp & 255u) == 0u) { if (xb_ld(&bar[XB_TMO])) break; if (sp > XB_SPIN_CAP) { atomicAdd(&bar[XB_TMO], 1u); break; } }
    }
    nloc = mine > 0u ? mine : 1u; nx = cnt > 0u ? cnt : 1u;
}
__device__ __forceinline__ void xcd_barrier(const XcdBarrier& b, const bool thread0) {
    asm volatile("s_waitcnt vmcnt(0)" ::: "memory");
    __syncthreads();
    if (thread0) {
        unsigned* bar = b.bar;
        __builtin_amdgcn_s_waitcnt(0);
        unsigned nloc = b.st[0], nx = b.st[1];
        if (nloc == 0u) { xcd_barrier_complete(bar, b.x, nloc, nx); b.st[0] = nloc; b.st[1] = nx; }
        const unsigned old = xb_add(&bar[XB_XSUB(b.x)], 1u);
        const unsigned gen = old / nloc;
        if (old + 1u == (gen + 1u) * nloc) {
            __builtin_amdgcn_fence(__ATOMIC_RELEASE, "agent");
            asm volatile("s_waitcnt vmcnt(0)" ::: "memory");
            const unsigned og = xb_add(&bar[XB_TOP], 1u);
            const unsigned tg = og / nx;
            if (og + 1u == (tg + 1u) * nx) xb_add(&bar[XB_TOPGEN], 1u);
            else XB_SPIN(xb_ld(&bar[XB_TOPGEN]) == tg, bar);
            __builtin_amdgcn_fence(__ATOMIC_ACQUIRE, "agent");
            xb_add(&bar[XB_XGEN(b.x)], 1u);
            asm volatile("s_waitcnt vmcnt(0)" ::: "memory");
        } else {
            XB_SPIN(xb_ld(&bar[XB_XGEN(b.x)]) == gen, bar);
            __builtin_amdgcn_fence(__ATOMIC_ACQUIRE, "agent");
            asm volatile("s_waitcnt vmcnt(0)" ::: "memory");
        }
    }
    __syncthreads();
}

struct Frame {
    LAS unsigned char* lds;
    unsigned* ctl;
    int tid, lane, wave, vcu, G;
    const float *x, *g1, *w_in, *gvn, *gsw, *gsb, *igb, *fgb, *ogn, *w_out, *g2, *rgw, *rgb, *rew, *reb, *wg, *wu, *wd, *gf;
    float* out;
    bf16_t *WIN_T, *WOUT_T, *WGU_T, *WD_T, *WRT, *ACT, *PROJ, *YT, *HM, *QH, *KH, *VH, *PM, *KP;
    float *GATES, *RSTD2, *AW, *HB, *VSSP, *GS; bf16_t* X1; int *LIST, *APOS;
};

struct TrDesc { const float* src; bf16_t* dst; int rk0; int ldw, ldt; };
__device__ __forceinline__ int gain_off(int k) { return (k >> 9) * 16640 + 8448 + 4 * (k & 511); }
__device__ __forceinline__ void tr_load(const TrDesc& d, f32x4 (&v)[16], int lane) {
    const GAS float* wp = (const GAS float*)d.src + (size_t)(lane >> 4) * d.ldw + 4 * (lane & 15);
#pragma unroll
    for (int i = 0; i < 16; ++i) v[i] = __builtin_nontemporal_load((const GAS f32x4*)(wp + (size_t)(4 * i) * d.ldw));
}
__device__ __forceinline__ void tr_store(const TrDesc& d, const f32x4 (&v)[16], LAS float* scr, int lane, LAS unsigned char* lds) {
    LAS unsigned* sw = (LAS unsigned*)scr + (lane >> 4) * 33 + 2 * (lane & 15);
    if (d.rk0 >= 0) { const LAS float* rs = (const LAS float*)(lds + gain_off(d.rk0)) + (lane >> 4);
#pragma unroll
        for (int i = 0; i < 16; ++i) { const float s = rs[4 * i]; sw[(4 * i) * 33 + 0] = cvtpk(v[i].x * s, v[i].y * s); sw[(4 * i) * 33 + 1] = cvtpk(v[i].z * s, v[i].w * s); } }
    else {
#pragma unroll
        for (int i = 0; i < 16; ++i) { sw[(4 * i) * 33 + 0] = cvtpk(v[i].x, v[i].y); sw[(4 * i) * 33 + 1] = cvtpk(v[i].z, v[i].w); } }
    LDS_WAIT();
    const int c = lane & 7;
#pragma unroll
    for (int j = 0; j < 4; ++j) { const int dcol = (lane >> 3) + 8 * j; const LAS unsigned* sr = (const LAS unsigned*)scr + (8 * c) * 33 + dcol;
        unsigned x[8];
#pragma unroll
        for (int kk = 0; kk < 8; ++kk) x[kk] = sr[kk * 33];
        u32x4 lo, hi;
        lo.x = (x[0] & 0xffffu) | (x[1] << 16); lo.y = (x[2] & 0xffffu) | (x[3] << 16); lo.z = (x[4] & 0xffffu) | (x[5] << 16); lo.w = (x[6] & 0xffffu) | (x[7] << 16);
        hi.x = (x[0] >> 16) | (x[1] & 0xffff0000u); hi.y = (x[2] >> 16) | (x[3] & 0xffff0000u); hi.z = (x[4] >> 16) | (x[5] & 0xffff0000u); hi.w = (x[6] >> 16) | (x[7] & 0xffff0000u);
        GAS bf16_t* op = (GAS bf16_t*)d.dst + (size_t)(2 * dcol) * d.ldt + 8 * c;
        __builtin_nontemporal_store(lo, (GAS u32x4*)op); __builtin_nontemporal_store(hi, (GAS u32x4*)(op + d.ldt)); }
    LDS_WAIT();
}
__device__ __forceinline__ void phase0(Frame& F) {
    LAS float* gwl = (LAS float*)F.lds;
#pragma unroll 4
    for (int idx = F.tid; idx < 8 * 4096; idx += 512) { const int k = idx >> 3, j = idx & 7; gwl[j * 4096 + k] = F.g1[k] * F.w_in[(size_t)k * LDW_IN + NPROJ + j]; }
    __syncthreads();
    const int gw = F.vcu * 8 + F.wave, NGW = F.G * 8;
    f32x4 v[16], vn[16];
    { const f32x4* xr0 = (const f32x4*)(F.x + (size_t)gw * DM) + F.lane;
#pragma unroll
      for (int j = 0; j < 16; ++j) v[j] = __builtin_nontemporal_load(xr0 + 64 * j); }
    for (int mm = gw; mm < PROBE0 * NTOK; mm += NGW) { const int m = mm & (NTOK - 1);
        const bool has = (mm + NGW) < PROBE0 * NTOK;
        if (has) { const f32x4* xr = (const f32x4*)(F.x + (size_t)((mm + NGW) & (NTOK - 1)) * DM) + F.lane;
#pragma unroll
            for (int j = 0; j < 16; ++j) vn[j] = __builtin_nontemporal_load(xr + 64 * j); }
        const f32x4* gr = (const f32x4*)F.g1 + F.lane;
        asm volatile("" : "+v"(gr));
        const LAS float* l0 = gwl + 4 * F.lane; const LAS float* l1 = l0 + 4 * 4096;
        asm volatile("" : "+v"(l0), "+v"(l1));
        float ss = 0.f; float ga[8]; f32x2 g2a[8];
#pragma unroll
        for (int c = 0; c < 8; ++c) g2a[c] = (f32x2){0.f, 0.f};
#pragma unroll
        for (int j = 0; j < 16; ++j) { const f32x4 y = v[j]; ss += (y.x * y.x + y.y * y.y) + (y.z * y.z + y.w * y.w);
#pragma unroll
            for (int c = 0; c < 4; ++c) { const f32x4 w = *(const LAS f32x4*)(l0 + 256 * j + c * 4096); g2a[c] += (f32x2){y.x, y.y} * (f32x2){w.x, w.y}; g2a[c] += (f32x2){y.z, y.w} * (f32x2){w.z, w.w}; }
#pragma unroll
            for (int c = 0; c < 4; ++c) { const f32x4 w = *(const LAS f32x4*)(l1 + 256 * j + c * 4096); g2a[4 + c] += (f32x2){y.x, y.y} * (f32x2){w.x, w.y}; g2a[4 + c] += (f32x2){y.z, y.w} * (f32x2){w.z, w.w}; }
            }
        ss = wave_sum(ss);
        const float rstd = 1.0f / sqrtf(ss * (1.0f / DM) + EPS);
#pragma unroll
        for (int c = 0; c < 8; ++c) ga[c] = wave_sum(g2a[c].x + g2a[c].y) * rstd;
        if (F.lane == 0) { f32x4* gp = (f32x4*)(F.GATES + (size_t)m * 8); gp[0] = (f32x4){ga[0], ga[1], ga[2], ga[3]}; gp[1] = (f32x4){ga[4], ga[5], ga[6], ga[7]}; }
        u32x2* o8 = (u32x2*)(F.ACT + (size_t)m * DM) + F.lane;
#pragma unroll
        for (int j0 = 0; j0 < 16; j0 += 8) {
#pragma unroll
            for (int j = j0; j < j0 + 8; ++j) { const f32x4 y = v[j] * rstd * gr[64 * j]; u32x2 o; o.x = cvtpk(y.x, y.y); o.y = cvtpk(y.z, y.w); o8[64 * j] = o; }
            asm volatile("" ::: "memory"); }
        if (has) {
#pragma unroll
            for (int j = 0; j < 16; ++j) v[j] = vn[j]; }
    }
    __syncthreads();
}
constexpr int I_IN = 64 * 160, I_OUT = 64 * 64, I_G = 64 * 512, I_U = I_G, I_D = 64 * 512;
constexpr int NITEMS = I_IN + I_OUT + I_G + I_U + I_D, ITEMS_DENSE = I_IN;
constexpr int NCONV = 72;
__device__ __forceinline__ void phase_convert(Frame& F, const int it_lo, const int it_hi, const int gw, const int NGW) {
    LAS float* scr = (LAS float*)(F.lds + F.wave * 16640);
    if (it_hi > ITEMS_DENSE + I_OUT) { __syncthreads(); for (int k = F.tid; k < DM; k += 512) *(LAS float*)(F.lds + gain_off(k)) = F.g2[k]; __syncthreads(); }
    auto decode = [&](int it) -> TrDesc {
        TrDesc d; int r = it;
        if (r < I_IN) { const int kb = r & 63, nb = r >> 6;   d.src = F.w_in + (size_t)(64 * kb) * LDW_IN + 64 * nb; d.rk0 = -1; d.ldw = LDW_IN; d.dst = F.WIN_T + (size_t)(64 * nb) * DM + 64 * kb; d.ldt = DM; return d; } r -= I_IN;
        if (r < I_OUT) { const int kb = r & 63, nb = r >> 6; d.src = F.w_out + (size_t)(64 * kb) * DM + 64 * nb; d.rk0 = -1; d.ldw = DM; d.dst = F.WOUT_T + (size_t)(64 * nb) * DM + 64 * kb; d.ldt = DM; return d; } r -= I_OUT;
        if (r < I_G + I_U) { const int up = (r >= I_G) ? 1 : 0; r -= up * I_G; const int e = r >> 9, q = r & 511, kb = (q >> 6) * 8 + (q & 7), n0 = ((q >> 3) & 7) * 64; const int drow = (n0 >> 7) * 256 + up * 128 + (n0 & 127);
            d.src = (up ? F.wu : F.wg) + (size_t)e * DM * DEXP + (size_t)(64 * kb) * DEXP + n0; d.rk0 = 64 * kb; d.ldw = DEXP; d.dst = F.WGU_T + (size_t)e * 1024 * DM + (size_t)drow * DM + 64 * kb; d.ldt = DM; return d; } r -= I_G + I_U;
        { const int e = r >> 9, q = r & 511, kb = q & 7, nb = q >> 3;
            d.src = F.wd + (size_t)e * DEXP * DM + (size_t)(64 * kb) * DM + 64 * nb; d.rk0 = -1; d.ldw = DM; d.dst = F.WD_T + (size_t)e * DM * DEXP + (size_t)(64 * nb) * DEXP + 64 * kb; d.ldt = DEXP; return d; }
    };
    if (NGW < 0) {
        const int per = (it_hi - it_lo + (-NGW) - 1) / (-NGW); int it = it_lo + gw * per; const int ie = (it + per < it_hi) ? it + per : it_hi;
        f32x4 va[16], vb[16], vc[16]; TrDesc da, db, dc;
        if (it < ie) { da = decode(it); tr_load(da, va, F.lane); }
        if (it + 1 < ie) { db = decode(it + 1); tr_load(db, vb, F.lane); }
        for (; it < ie; it += 3) {
            if (it + 2 < ie) { dc = decode(it + 2); tr_load(dc, vc, F.lane); }
            tr_store(da, va, scr, F.lane, F.lds);
            if (it + 1 >= ie) break;
            if (it + 3 < ie) { da = decode(it + 3); tr_load(da, va, F.lane); }
            tr_store(db, vb, scr, F.lane, F.lds);
            if (it + 2 >= ie) break;
            if (it + 4 < ie) { db = decode(it + 4); tr_load(db, vb, F.lane); }
            tr_store(dc, vc, scr, F.lane, F.lds);
        }
        return; }
    { f32x4 va[16], vb[16]; TrDesc d0, d1; int it = it_lo + gw;
      if (it < it_hi) { d0 = decode(it); tr_load(d0, va, F.lane); }
      for (; it < it_hi; it += NGW) {
          const bool has = (it + NGW) < it_hi;
          if (has) { d1 = decode(it + NGW); tr_load(d1, vb, F.lane); }
          tr_store(d0, va, scr, F.lane, F.lds);
          if (has) { d0 = d1;
#pragma unroll
              for (int i = 0; i < 16; ++i) va[i] = vb[i]; }
      } }
}
__device__ __forceinline__ void phase0b(Frame& F) {
    phase_convert(F, 0, ITEMS_DENSE, F.vcu * 8 + F.wave, -(F.G * 8));
#pragma unroll 2
    for (int idx = F.vcu * 512 + F.tid; idx < 80 * 4096; idx += F.G * 512) { const int n = idx >> 12, k = idx & 4095;
        const float v = (n < 8) ? F.rgw[k * 8 + n] : ((n < 72) ? F.rew[k * 64 + (n - 8)] : 0.f); F.WRT[idx] = (bf16_t)f2bf(v * F.g2[k]); }
}

typedef short v4i16_t __attribute__((ext_vector_type(4)));
__device__ __forceinline__ bf16x8 tr_bfrag(const LAS bf16_t* p0, const LAS bf16_t* p1) {
    const v4i16_t a = __builtin_amdgcn_ds_read_tr16_b64_v4i16((LAS v4i16_t*)p0), b = __builtin_amdgcn_ds_read_tr16_b64_v4i16((LAS v4i16_t*)p1);
    bf16x8 o; o[0] = a[0]; o[1] = a[1]; o[2] = a[2]; o[3] = a[3]; o[4] = b[0]; o[5] = b[1]; o[6] = b[2]; o[7] = b[3]; return o;
}
__device__ __forceinline__ void phase_gmlp(Frame& F) {
    LAS bf16_t* Wl = (LAS bf16_t*)(F.lds);
    LAS bf16_t* VT = (LAS bf16_t*)(F.lds + 34816);
    LAS float* rs = (LAS float*)(F.lds + 69632);
    LAS float* Zt = (LAS float*)(F.lds + 70144);
    const int r = F.lane & 15, g4 = F.lane >> 4;
    for (int unit = blockIdx.x; unit < 512; unit += F.G) {
        const int g = unit & 15, cb = unit >> 4;
#pragma unroll
        for (int i = 0; i < 8; ++i) { const int idx = F.tid + 512 * i, t = idx >> 5, sc = (idx & 31) * 4;
            f32x4 w = *(const f32x4*)(F.gsw + (size_t)g * 16384 + t * 128 + sc);
            w.x = (sc + 0 <= t) ? w.x : 0.f; w.y = (sc + 1 <= t) ? w.y : 0.f; w.z = (sc + 2 <= t) ? w.z : 0.f; w.w = (sc + 3 <= t) ? w.w : 0.f;
            u32x2 o; o.x = cvtpk(w.x, w.y); o.y = cvtpk(w.z, w.w); *(LAS u32x2*)(Wl + t * 136 + sc) = o; }
        u32x4 vraw[4], uraw[4]; f32x4 pp[8];
#define GM_PREFETCH_V(chn) do { const int r0n = (4 * cb + (chn)) * 128; \
            _Pragma("unroll") for (int i = 0; i < 4; ++i) { const int idx_ = F.tid + 512 * i; vraw[i] = __builtin_nontemporal_load((const u32x4*)(F.PROJ + (size_t)(r0n + (idx_ >> 4)) * NPROJ + C_V + g * 128 + (idx_ & 15) * 8)); } \
            if (F.tid < 128) { const f32x4* pq = (const f32x4*)(F.VSSP + (size_t)(r0n + F.tid) * 32); _Pragma("unroll") for (int q = 0; q < 8; ++q) pp[q] = pq[q]; } } while (0)
        GM_PREFETCH_V(0);
        LDS_BARRIER();
#pragma unroll
        for (int ch = 0; ch < 4; ++ch) {
            const int r0 = (4 * cb + ch) * 128;
            if (F.tid < 128) { float ss = 0.f;
#pragma unroll
                for (int q = 0; q < 8; ++q) ss += (pp[q].x + pp[q].y) + (pp[q].z + pp[q].w);
                rs[F.tid] = 1.0f / sqrtf(ss * (1.0f / 2048.0f) + EPS); }
            LDS_BARRIER();
            { const int d8 = (F.tid & 15) * 8;
              const f32x4 gva = *(const f32x4*)(F.gvn + g * 128 + d8), gvb = *(const f32x4*)(F.gvn + g * 128 + d8 + 4);
#pragma unroll
              for (int i = 0; i < 4; ++i) { const int t = (F.tid >> 4) + 32 * i; const float scl = rs[t];
                const u32x4 raw = vraw[i]; const f32x4 ga = gva * scl, gb = gvb * scl;
                u32x4 o; o.x = cvtpk(bf_lo(raw.x) * ga.x, bf_hi(raw.x) * ga.y); o.y = cvtpk(bf_lo(raw.y) * ga.z, bf_hi(raw.y) * ga.w); o.z = cvtpk(bf_lo(raw.z) * gb.x, bf_hi(raw.z) * gb.y); o.w = cvtpk(bf_lo(raw.w) * gb.z, bf_hi(raw.w) * gb.w);
                *(LAS u32x4*)(VT + t * 136 + d8) = o; } }
#pragma unroll
            for (int i = 0; i < 4; ++i) { const int idx = F.tid + 512 * i; uraw[i] = __builtin_nontemporal_load((const u32x4*)(F.PROJ + (size_t)(r0 + (idx >> 4)) * NPROJ + C_U + g * 128 + (idx & 15) * 8)); }
            if (ch + 1 < 4) GM_PREFETCH_V(ch + 1);
            LDS_BARRIER();
            const int t0 = 16 * F.wave, nks = (F.wave >> 1) + 1;
            f32x4 acc[8];
#pragma unroll
            for (int dt = 0; dt < 8; ++dt) acc[dt] = (f32x4){0.f, 0.f, 0.f, 0.f};
            for (int ks = 0; ks < nks; ++ks) {
                const bf16x8 A = *(const LAS bf16x8*)(Wl + (t0 + r) * 136 + 32 * ks + 8 * g4);
                bf16x8 B[8];
#pragma unroll
                for (int dt = 0; dt < 8; ++dt) { const LAS bf16_t* bp = VT + (32 * ks + 8 * g4 + (r >> 2)) * 136 + 16 * dt + 4 * (r & 3); B[dt] = tr_bfrag(bp, bp + 4 * 136); }
                __builtin_amdgcn_sched_barrier(0);
#pragma unroll
                for (int dt = 0; dt < 8; ++dt) acc[dt] = mfma16(A, B[dt], acc[dt]);
                __builtin_amdgcn_sched_barrier(0); }
#pragma unroll
            for (int rr = 0; rr < 4; ++rr) { const int t = t0 + 4 * g4 + rr; const float bias = F.gsb[g * 128 + t];
#pragma unroll
                for (int dt = 0; dt < 8; ++dt) Zt[t * 132 + 16 * dt + r] = acc[dt][rr] + bias; }
            LDS_BARRIER();
#pragma unroll
            for (int i = 0; i < 4; ++i) { const int idx = F.tid + 512 * i, t = idx >> 4, d8 = (idx & 15) * 8;
                const u32x4 uu = uraw[i];
                const f32x4 z0 = *(const LAS f32x4*)(Zt + t * 132 + d8), z1 = *(const LAS f32x4*)(Zt + t * 132 + d8 + 4);
                u32x4 o; o.x = cvtpk(bf_lo(uu.x) * z0.x, bf_hi(uu.x) * z0.y); o.y = cvtpk(bf_lo(uu.y) * z0.z, bf_hi(uu.y) * z0.w); o.z = cvtpk(bf_lo(uu.z) * z1.x, bf_hi(uu.z) * z1.y); o.w = cvtpk(bf_lo(uu.w) * z1.z, bf_hi(uu.w) * z1.w);
                *(u32x4*)(F.ACT + (size_t)(r0 + t) * DM + g * 128 + d8) = o; }
        }
#undef GM_PREFETCH_V
        __syncthreads();
    }
}

__device__ __forceinline__ float softcap15(float z) { return 15.0f * tanhf(z * (1.0f / 15.0f)); }
__device__ __forceinline__ void phase_gates(Frame& F, const int bh) {
    LAS float* SA = (LAS float*)(F.lds);
    LAS float* SM = (LAS float*)(F.lds + 16384);
    LAS float* SFL = (LAS float*)(F.lds + 32768);
    LAS float* scr = (LAS float*)(F.lds + 134144);
    const int tid = F.tid, lane = F.lane, wave = F.wave, b = bh >> 2, hh = bh & 3, rowb = b * SEQL;
    __syncthreads();
        { const float igb = F.igb[hh], fgb = F.fgb[hh];
          float cs[8], av[8]; float run = 0.f;
          float gi8[8], gf8[8];
#pragma unroll
          for (int k = 0; k < 8; ++k) { const float* gp = F.GATES + (size_t)(rowb + 8 * tid + k) * 8; gi8[k] = gp[hh]; gf8[k] = gp[4 + hh]; }
#pragma unroll
          for (int k = 0; k < 8; ++k) { const float zf = softcap15(gf8[k] + fgb); run += -log1pf(expf(-zf)); cs[k] = run; av[k] = softcap15(gi8[k] + igb); }
          float incl = run;
#pragma unroll
          for (int o = 1; o < 64; o <<= 1) { const float t = __shfl_up(incl, o); if (lane >= o) incl += t; }
          if (lane == 63) scr[wave] = incl;
          __syncthreads();
          float base = incl - run;
          for (int w = 0; w < wave; ++w) base += scr[w];
          float Bv[8]; float runm = -3.0e38f; float mx[8];
#pragma unroll
          for (int k = 0; k < 8; ++k) { Bv[k] = base + cs[k]; av[k] = av[k] - Bv[k]; runm = fmaxf(runm, av[k]); mx[k] = runm; }
          float inclm = runm;
#pragma unroll
          for (int o = 1; o < 64; o <<= 1) { const float t = __shfl_up(inclm, o); if (lane >= o) inclm = fmaxf(inclm, t); }
          float exclm = __shfl_up(inclm, 1); if (lane == 0) exclm = -3.0e38f;
          if (lane == 63) scr[8 + wave] = inclm;
          __syncthreads();
          float basem = fmaxf(0.f, exclm);
          for (int w = 0; w < wave; ++w) basem = fmaxf(basem, scr[8 + w]);
          float Mv[8], flv[8];
#pragma unroll
          for (int k = 0; k < 8; ++k) { Mv[k] = fmaxf(basem, mx[k]); flv[k] = expf(-(Bv[k] + Mv[k])); }
          *(LAS f32x4*)(SA + 8 * tid) = (f32x4){av[0], av[1], av[2], av[3]}; *(LAS f32x4*)(SA + 8 * tid + 4) = (f32x4){av[4], av[5], av[6], av[7]};
          *(LAS f32x4*)(SM + 8 * tid) = (f32x4){Mv[0], Mv[1], Mv[2], Mv[3]}; *(LAS f32x4*)(SM + 8 * tid + 4) = (f32x4){Mv[4], Mv[5], Mv[6], Mv[7]};
          *(LAS f32x4*)(SFL + 8 * tid) = (f32x4){flv[0], flv[1], flv[2], flv[3]}; *(LAS f32x4*)(SFL + 8 * tid + 4) = (f32x4){flv[4], flv[5], flv[6], flv[7]}; }
    __syncthreads();
    { f32x4* gs = (f32x4*)(F.GS + (size_t)bh * 3 * 4096);
#pragma unroll
      for (int i = 0; i < 6; ++i) gs[tid + 512 * i] = *(const LAS f32x4*)(SA + 4 * (tid + 512 * i)); }
    __syncthreads();
}
__device__ __forceinline__ void phase_mlstm_pre(Frame& F) {
    LAS bf16_t* Kc = (LAS bf16_t*)(F.lds);
    LAS bf16_t* Qc = (LAS bf16_t*)(F.lds + 67584);
    const int wave = F.wave, pp = (wave < 4) ? wave : 7 - wave, hi = wave >> 2;
    for (int unit = F.vcu; unit < 256; unit += F.G) {
        const int bh = unit >> 4, es = unit & 15;
        int ln_ = F.lane; asm volatile("" : "+v"(ln_));
        const int r = ln_ & 15, g4 = ln_ >> 4, tid = wave * 64 + ln_;
        const float* ga = F.GS + (size_t)bh * 3 * 4096; const float* gm = ga + 4096;
        u32x4 kreg[8], qreg[8];
#define MP_LOAD(c) do { const char* kb_ = (const char*)(F.KH + (size_t)bh * SEQL * 256) + (size_t)(c) * 65536; const char* qb_ = (const char*)(F.QH + (size_t)bh * SEQL * 256) + (size_t)(c) * 65536; \
        _Pragma("unroll") for (int i = 0; i < 8; ++i) { kreg[i] = *(const u32x4*)(kb_ + 8192 * i + 16u * (unsigned)tid); qreg[i] = *(const u32x4*)(qb_ + 8192 * i + 16u * (unsigned)tid); } } while (0)
        MP_LOAD(es * 2);
        for (int t = 0; t < 2; ++t) {
            const int c = es * 2 + t, pb = 128 * c;
            char* kp_ = (char*)(F.KP + (size_t)bh * SEQL * 256) + (size_t)c * 65536;
            const float Mend = gm[pb + 127];
            __syncthreads();
#pragma unroll
            for (int i = 0; i < 8; ++i) { const int rowo = 16 * i;
                *(LAS u32x4*)(Kc + (tid >> 5) * 264 + 8 * (tid & 31) + rowo * 264) = kreg[i]; *(LAS u32x4*)(Qc + (tid >> 5) * 264 + 8 * (tid & 31) + rowo * 264) = qreg[i];
                const float wt = fast_exp(ga[pb + (tid >> 5) + rowo] - Mend); u32x4 kw;
                kw.x = cvtpk(bf_lo(kreg[i].x) * wt, bf_hi(kreg[i].x) * wt); kw.y = cvtpk(bf_lo(kreg[i].y) * wt, bf_hi(kreg[i].y) * wt); kw.z = cvtpk(bf_lo(kreg[i].z) * wt, bf_hi(kreg[i].z) * wt); kw.w = cvtpk(bf_lo(kreg[i].w) * wt, bf_hi(kreg[i].w) * wt);
                *(u32x4*)(kp_ + 8192 * i + 16u * (unsigned)tid) = kw; }
            LDS_BARRIER();
            if (t == 0) MP_LOAD(c + 1);
#pragma unroll
            for (int part = 0; part < 2; ++part) {
                const int rt = part ? 7 - pp : pp;
                const int jlo = part ? (hi ? 4 - pp : 0) : 0, jhi = part ? (hi ? 7 - pp : 3 - pp) : (hi ? -1 : pp);
                if (jlo <= jhi) {
                    const int i0 = 16 * rt;
                    bf16x8 Qf[8];
#pragma unroll
                    for (int ks = 0; ks < 8; ++ks) Qf[ks] = *(const LAS bf16x8*)(Qc + (i0 + r) * 264 + 32 * ks + 8 * g4);
                    bf16_t* Pg = F.PM + ((size_t)bh * 32 + c) * 16384 + (size_t)(i0 + r) * 128 + 4 * g4;
                    const float Mi = gm[pb + i0 + r]; const int irow = i0 + r;
                    for (int jt = jlo; jt <= jhi; ++jt) {
                        bf16x8 Kf[8];
#pragma unroll
                        for (int ks = 0; ks < 8; ++ks) Kf[ks] = *(const LAS bf16x8*)(Kc + (16 * jt + r) * 264 + 32 * ks + 8 * g4);
                        const f32x4 a4 = *(const f32x4*)(ga + pb + 16 * jt + 4 * g4);
                        __builtin_amdgcn_sched_barrier(0);
                        f32x4 sv = (f32x4){0.f, 0.f, 0.f, 0.f};
#pragma unroll
                        for (int ks = 0; ks < 8; ++ks) sv = mfma16(Kf[ks], Qf[ks], sv);
                        __builtin_amdgcn_sched_barrier(0);
                        float p[4];
#pragma unroll
                        for (int rr = 0; rr < 4; ++rr) p[rr] = (16 * jt + 4 * g4 + rr <= irow) ? sv[rr] * fast_exp(a4[rr] - Mi) : 0.f;
                        u32x2 w; w.x = cvtpk(p[0], p[1]); w.y = cvtpk(p[2], p[3]);
                        *(u32x2*)(Pg + 16 * jt) = w; }
                    if (jhi == rt && (rt & 1) == 0) *(u32x2*)(Pg + 16 * (rt + 1)) = (u32x2){0u, 0u};
                } }
        }
#undef MP_LOAD
    }
    __syncthreads();
}
__device__ __forceinline__ void phase_mlstm(Frame& F) {
    LAS float* SM = (LAS float*)(F.lds);
    LAS float* SFL = (LAS float*)(F.lds + 16384);
    LAS bf16_t* Kc = (LAS bf16_t*)(F.lds + 32768);
    LAS bf16_t* CT = (LAS bf16_t*)(F.lds + 100352);
    LAS bf16_t* NV = (LAS bf16_t*)(F.lds + 117248);
    LAS bf16_t* Vc = (LAS bf16_t*)(F.lds + 117760);
    const int wave = F.wave;
    const int rt = (wave < 4) ? wave : 11 - wave, i0 = 16 * rt, nks0 = (rt >> 1) + 1, et = wave >> 2, dq = wave & 3;
    for (int unit = F.vcu; unit < 256; unit += F.G) {
        const int b = unit >> 6, hh = (unit >> 4) & 3, es = unit & 15, e0 = es * 32, bh = b * 4 + hh;
        const int rowb = b * SEQL;
        int ln_ = F.lane; asm volatile("" : "+v"(ln_));
        const int r = ln_ & 15, g4 = ln_ >> 4, tid = wave * 64 + ln_;
        __syncthreads();
        { const f32x4* gs = (const f32x4*)(F.GS + (size_t)bh * 3 * 4096 + 4096);
#pragma unroll
          for (int i = 0; i < 4; ++i) *(LAS f32x4*)(SM + 4 * (tid + 512 * i)) = gs[tid + 512 * i]; }
        for (int idx = tid; idx < 32 * 264; idx += 512) CT[idx] = 0;
        if (tid < 256) NV[tid] = 0;
        __syncthreads();
        const char* Kp = (const char*)(F.KP + (size_t)bh * SEQL * 256); const unsigned kvo = 16u * (unsigned)tid;
        const char* Vp = (const char*)(F.VH + (size_t)bh * SEQL * 512 + e0); const unsigned vvo = (unsigned)((tid >> 2) * 1024 + (tid & 3) * 16);
        const char* Qp = (const char*)(F.QH + (size_t)bh * SEQL * 256) + i0 * 512; const unsigned qvo = (unsigned)(r * 512 + 16 * g4);
        const char* Pp = (const char*)(F.PM + (size_t)bh * 32 * 16384) + i0 * 256; const unsigned pvo = (unsigned)(r * 256 + 16 * g4);
        f32x4 accC[4], accN[4];
#pragma unroll
        for (int dd = 0; dd < 4; ++dd) { accC[dd] = (f32x4){0.f, 0.f, 0.f, 0.f}; accN[dd] = (f32x4){0.f, 0.f, 0.f, 0.f}; }
        u32x4 kreg[8], vreg, Qr[8], Pr[4];
#pragma unroll
        for (int ks = 0; ks < 4; ++ks) Pr[ks] = (u32x4){0u, 0u, 0u, 0u};
#define ML_LOADKV(c) do { const char* kb_ = Kp + (size_t)(c) * 65536; _Pragma("unroll") for (int i = 0; i < 8; ++i) kreg[i] = *(const u32x4*)(kb_ + 8192 * i + kvo); vreg = *(const u32x4*)(Vp + (size_t)(c) * 131072 + vvo); } while (0)
#define ML_LOADQ(c) do { const char* qb_ = Qp + (size_t)(c) * 65536; _Pragma("unroll") for (int ks = 0; ks < 8; ++ks) Qr[ks] = *(const u32x4*)(qb_ + 64 * ks + qvo); } while (0)
#define ML_LOADP(c) do { const char* pb_ = Pp + (size_t)(c) * 32768; _Pragma("unroll") for (int ks = 0; ks < 4; ++ks) if (ks < nks) Pr[ks] = *(const u32x4*)(pb_ + 64 * ks + pvo); } while (0)
        { const int nks = nks0; ML_LOADKV(0); ML_LOADQ(0); ML_LOADP(0); }
        __builtin_amdgcn_s_waitcnt(0);
        for (int c = 0; c < 32; ++c) {
            const int pb = 128 * c;
            int nks = nks0; asm volatile("" : "+s"(nks));
#pragma unroll
            for (int i = 0; i < 8; ++i) *(LAS u32x4*)(Kc + (tid >> 5) * 264 + 8 * (tid & 31) + i * (16 * 264)) = kreg[i];
            *(LAS u32x4*)(Vc + (tid >> 2) * 48 + 8 * (tid & 3)) = vreg;
            LDS_BARRIER();
            if (c + 1 < 32) { ML_LOADKV(c + 1); }
            const float Rc = (c == 0) ? 0.f : SM[pb - 1]; const float Rn = SM[pb + 127]; const float decay = fast_exp(Rc - Rn);
            const bf16x8 ones = (bf16x8){(short)0x3f80, (short)0x3f80, (short)0x3f80, (short)0x3f80, (short)0x3f80, (short)0x3f80, (short)0x3f80, (short)0x3f80};
            {
#pragma unroll
              for (int dd = 0; dd < 4; ++dd) { accC[dd] = accC[dd] * decay; accN[dd] = accN[dd] * decay; }
#pragma unroll
              for (int ks = 0; ks < 4; ++ks) { bf16x8 Kb[4];
                  const LAS bf16_t* wp = Vc + (32 * ks + 8 * g4 + (r >> 2)) * 48 + 16 * et + 4 * (r & 3); const bf16x8 Aw = tr_bfrag(wp, wp + 4 * 48);
                  const LAS bf16_t* kp = Kc + (32 * ks + 8 * g4 + (r >> 2)) * 264 + 64 * dq + 4 * (r & 3);
#pragma unroll
                  for (int dd = 0; dd < 4; ++dd) Kb[dd] = tr_bfrag(kp + 16 * dd, kp + 4 * 264 + 16 * dd);
#pragma unroll
                  for (int dd = 0; dd < 4; ++dd) accC[dd] = mfma16(Kb[dd], Aw, accC[dd]);
                  if (et == 0) {
#pragma unroll
                      for (int dd = 0; dd < 4; ++dd) accN[dd] = mfma16(Kb[dd], ones, accN[dd]); } }
            }
            __builtin_amdgcn_sched_barrier(0);
            bf16x8 R[8];
#pragma unroll
            for (int ks = 0; ks < 8; ++ks) R[ks] = *(const LAS bf16x8*)(CT + r * 264 + 32 * ks + 8 * g4);
            f32x4 o1a = (f32x4){0.f, 0.f, 0.f, 0.f}, o1b = o1a, o2a = o1a, o2b = o1a, qn = o1a, dsum = o1a;
            __builtin_amdgcn_sched_barrier(0);
#define ML_SEG(MF, NEXTREAD) do { _Pragma("unroll") for (int ks = 0; ks < 8; ++ks) { MF; NEXTREAD; __builtin_amdgcn_sched_barrier(0); } } while (0)
            ML_SEG(o2a = mfma16(__builtin_bit_cast(bf16x8, Qr[ks]), R[ks], o2a), R[ks] = *(const LAS bf16x8*)(CT + (16 + r) * 264 + 32 * ks + 8 * g4));
            ML_SEG(o2b = mfma16(__builtin_bit_cast(bf16x8, Qr[ks]), R[ks], o2b), R[ks] = *(const LAS bf16x8*)(NV + 32 * ks + 8 * g4));
            { const LAS bf16_t* vp = Vc + (8 * g4 + (r >> 2)) * 48 + 4 * (r & 3);
#pragma unroll
              for (int ks = 0; ks < 4; ++ks) if (ks < nks) { const bf16x8 Ap = __builtin_bit_cast(bf16x8, Pr[ks]);
                  const bf16x8 Bva = tr_bfrag(vp + 32 * ks * 48, vp + (32 * ks + 4) * 48), Bvb = tr_bfrag(vp + 32 * ks * 48 + 16, vp + (32 * ks + 4) * 48 + 16);
                  o1a = mfma16(Ap, Bva, o1a); o1b = mfma16(Ap, Bvb, o1b); dsum = mfma16(Ap, ones, dsum); } }
            __builtin_amdgcn_sched_barrier(0);
            if (c + 1 < 32) { ML_LOADP(c + 1); }
            ML_SEG(qn = mfma16(__builtin_bit_cast(bf16x8, Qr[ks]), R[ks], qn), (void)0);
#undef ML_SEG
            __builtin_amdgcn_sched_barrier(0);
            if (c + 1 < 32) { ML_LOADQ(c + 1); }
            { const f32x4 Mi4 = *(const LAS f32x4*)(SM + pb + i0 + 4 * g4), fl4 = *(const LAS f32x4*)(SFL + pb + i0 + 4 * g4);
              char* hb_ = (char*)((bf16_t*)F.HB + (size_t)(rowb + pb + i0) * 2048 + hh * 512 + e0); const unsigned hvoff = (unsigned)(4 * g4) * 4096u + 2u * (unsigned)r;
#pragma unroll
              for (int rr = 0; rr < 4; ++rr) { const float wir = fast_exp(Rc - Mi4[rr]);
                  const float den = wir * qn[rr] + dsum[rr]; const float inv = __builtin_amdgcn_rcpf(fmaxf(fabsf(den), fl4[rr]));
                  const unsigned hp_ = cvtpk((o1a[rr] + wir * o2a[rr]) * inv, (o1b[rr] + wir * o2b[rr]) * inv);
                  *(bf16_t*)(hb_ + (hvoff + 4096u * rr)) = (bf16_t)(hp_ & 0xffffu); *(bf16_t*)(hb_ + (hvoff + 4096u * rr) + 32) = (bf16_t)(hp_ >> 16); } }
            {
              LDS_BARRIER();
#pragma unroll
              for (int dd = 0; dd < 4; ++dd) { u32x2 cw; cw.x = cvtpk(accC[dd][0], accC[dd][1]); cw.y = cvtpk(accC[dd][2], accC[dd][3]);
                  *(LAS u32x2*)(CT + (16 * et + r) * 264 + 16 * (4 * dq + dd) + 4 * g4) = cw; }
              if (et == 0 && r == 0) {
#pragma unroll
                  for (int dd = 0; dd < 4; ++dd) { u32x2 nw; nw.x = cvtpk(accN[dd][0], accN[dd][1]); nw.y = cvtpk(accN[dd][2], accN[dd][3]); *(LAS u32x2*)(NV + 16 * (4 * dq + dd) + 4 * g4) = nw; } } }
        }
#undef ML_LOADKV
#undef ML_LOADQ
#undef ML_LOADP
        __syncthreads();
    }
}
__device__ __forceinline__ void phase_mlnorm(Frame& F) {
    const int gw = F.vcu * 8 + F.wave, NGW = F.G * 8;
    f32x4 gg[8];
#pragma unroll
    for (int hh = 0; hh < 4; ++hh) { const f32x4* gp = (const f32x4*)(F.ogn + hh * 512) + F.lane; gg[2 * hh] = gp[0]; gg[2 * hh + 1] = gp[64]; }
    u32x2 ha[8], oa[8], hb[8], ob[8];
#define MN_LOAD(m, H, O) do { _Pragma("unroll") for (int hh = 0; hh < 4; ++hh) { \
        const u32x2* hp = (const u32x2*)((const bf16_t*)F.HB + (size_t)(m) * 2048 + hh * 512) + F.lane; H[2 * hh] = __builtin_nontemporal_load(hp); H[2 * hh + 1] = __builtin_nontemporal_load(hp + 64); \
        const u32x2* op = (const u32x2*)(F.PROJ + (size_t)(m) * NPROJ + C_O + hh * 512) + F.lane; O[2 * hh] = __builtin_nontemporal_load(op); O[2 * hh + 1] = __builtin_nontemporal_load(op + 64); } } while (0)
    int m = gw;
    if (m < NTOK) MN_LOAD(m, ha, oa);
    for (; m < NTOK; m += NGW) {
        const bool has = (m + NGW) < NTOK;
        if (has) MN_LOAD(m + NGW, hb, ob);
#pragma unroll
        for (int hh = 0; hh < 4; ++hh) {
            const u32x2 h0 = ha[2 * hh], h1 = ha[2 * hh + 1];
            const f32x4 v0 = (f32x4){bf_lo(h0.x), bf_hi(h0.x), bf_lo(h0.y), bf_hi(h0.y)}, v1 = (f32x4){bf_lo(h1.x), bf_hi(h1.x), bf_lo(h1.y), bf_hi(h1.y)};
            float ss = (v0.x * v0.x + v0.y * v0.y) + (v0.z * v0.z + v0.w * v0.w) + (v1.x * v1.x + v1.y * v1.y) + (v1.z * v1.z + v1.w * v1.w);
            ss = wave_sum(ss);
            const float rstd = 1.0f / sqrtf(ss * (1.0f / 512.0f) + EPS);
            const f32x4 g0 = gg[2 * hh], g1 = gg[2 * hh + 1]; const u32x2 s0 = oa[2 * hh], s1 = oa[2 * hh + 1];
            u32x2* yp = (u32x2*)(F.ACT + (size_t)m * DM + 2048 + hh * 512) + F.lane;
            u32x2 o;
            o.x = pk2(v0.x * rstd * g0.x * bf_lo(s0.x), v0.y * rstd * g0.y * bf_hi(s0.x)); o.y = pk2(v0.z * rstd * g0.z * bf_lo(s0.y), v0.w * rstd * g0.w * bf_hi(s0.y)); yp[0] = o;
            o.x = pk2(v1.x * rstd * g1.x * bf_lo(s1.x), v1.y * rstd * g1.y * bf_hi(s1.x)); o.y = pk2(v1.z * rstd * g1.z * bf_lo(s1.y), v1.w * rstd * g1.w * bf_hi(s1.y)); yp[64] = o;
        }
        if (has) {
#pragma unroll
            for (int i = 0; i < 8; ++i) { ha[i] = hb[i]; oa[i] = ob[i]; } }
    }
#undef MN_LOAD
}

__device__ __forceinline__ void phase_router(Frame& F) {
    const int lane = F.lane, tid = F.tid, r = lane & 15, g4 = lane >> 4, pair = F.wave >> 1, half = F.wave & 1;
    LAS unsigned char* Bb = F.lds;
    LAS float* lg = (LAS float*)(F.lds + 40960) + F.wave * (16 * 81 + 16);
    for (int task = F.vcu * 4 + pair; task < NTOK / 16; task += F.G * 4) {
        const int row0 = task * 16;
        const bf16_t* xrow = F.X1 + (size_t)(row0 + r) * DM + half * 64 + 8 * g4;
        const int rotc = (F.vcu * 5) & 31;
        f32x4 acc[5];
#pragma unroll
        for (int nt = 0; nt < 5; ++nt) acc[nt] = (f32x4){0.f, 0.f, 0.f, 0.f};
        float ss = 0.f;
        u32x4 bs0[3], bs1[3], bs2[3], bs3[3], x0[2], x1[2], x2[2], x3[2];
#define RT_KC(cc) (((cc) + rotc) & 31)
#define RT_BLOAD(BS, cc) do { const bf16_t* wp_ = F.WRT + (size_t)RT_KC(cc) * 128; _Pragma("unroll") for (int q = 0; q < 3; ++q) { const int gc = tid + 512 * q; \
            if (gc < 1280) BS[q] = *(const u32x4*)(wp_ + (size_t)(gc >> 4) * DM + (gc & 15) * 8); } } while (0)
#define RT_BWRITE(BS, buf) do { _Pragma("unroll") for (int q = 0; q < 3; ++q) { const int gc = tid + 512 * q, rw = gc >> 4, ch = gc & 15; \
            if (gc < 1280) *(LAS u32x4*)(Bb + (buf) * 20480 + rw * 256 + ((ch ^ (rw & 15)) << 4)) = BS[q]; } } while (0)
#define RT_XLOAD(X, cc) do { const bf16_t* xp_ = xrow + (size_t)RT_KC(cc) * 128; X[0] = *(const u32x4*)(xp_); X[1] = *(const u32x4*)(xp_ + 32); } while (0)
#define RT_STEP(cc, X, BSN) do { const LAS unsigned char* bp_ = Bb + ((cc) & 1) * 20480 + r * 256; \
            bf16x8 bfr_[2][5]; \
            _Pragma("unroll") for (int u = 0; u < 2; ++u) { const int sl_ = ((((half * 2 + u) * 4 + g4) ^ r) << 4); \
                _Pragma("unroll") for (int nt = 0; nt < 5; ++nt) bfr_[u][nt] = *(const LAS bf16x8*)(bp_ + nt * 4096 + sl_); } \
            _Pragma("unroll") for (int u = 0; u < 2; ++u) { \
                const float a0 = bf_lo(X[u].x), a1 = bf_hi(X[u].x), a2 = bf_lo(X[u].y), a3 = bf_hi(X[u].y), a4 = bf_lo(X[u].z), a5 = bf_hi(X[u].z), a6 = bf_lo(X[u].w), a7 = bf_hi(X[u].w); \
                ss += ((a0 * a0 + a1 * a1) + (a2 * a2 + a3 * a3)) + ((a4 * a4 + a5 * a5) + (a6 * a6 + a7 * a7)); } \
            __builtin_amdgcn_sched_barrier(0); \
            _Pragma("unroll") for (int u = 0; u < 2; ++u) { const bf16x8 af = __builtin_bit_cast(bf16x8, X[u]); \
                _Pragma("unroll") for (int nt = 0; nt < 5; ++nt) acc[nt] = mfma16(af, bfr_[u][nt], acc[nt]); } \
            __builtin_amdgcn_sched_barrier(0); \
            if ((cc) + 4 < 32) RT_XLOAD(X, (cc) + 4); \
            if ((cc) + 1 < 32) { RT_BWRITE(BSN, ((cc) + 1) & 1); if ((cc) + 5 < 32) RT_BLOAD(BSN, (cc) + 5); } \
            LDS_BARRIER(); } while (0)
        __syncthreads();
        RT_BLOAD(bs0, 0); RT_BLOAD(bs1, 1); RT_BLOAD(bs2, 2); RT_BLOAD(bs3, 3); RT_XLOAD(x0, 0); RT_XLOAD(x1, 1); RT_XLOAD(x2, 2); RT_XLOAD(x3, 3);
        RT_BWRITE(bs0, 0); RT_BLOAD(bs0, 4);
        LDS_BARRIER();
#pragma unroll 1
        for (int c0 = 0; c0 < 32; c0 += 4) { RT_STEP(c0, x0, bs1); RT_STEP(c0 + 1, x1, bs2); RT_STEP(c0 + 2, x2, bs3); RT_STEP(c0 + 3, x3, bs0); }
#undef RT_KC
#undef RT_BLOAD
#undef RT_BWRITE
#undef RT_XLOAD
#undef RT_STEP
        ss += __shfl_xor(ss, 16); ss += __shfl_xor(ss, 32);
#pragma unroll
        for (int nt = 0; nt < 5; ++nt)
#pragma unroll
            for (int rr = 0; rr < 4; ++rr) lg[(4 * g4 + rr) * 81 + 16 * nt + r] = acc[nt][rr];
        if (lane < 16) lg[16 * 81 + lane] = ss;
        __syncthreads();
        if (half == 0 && lane < 16) {
            const int token = row0 + lane; const LAS float* lr = lg + lane * 81; const LAS float* lr2 = lr + (16 * 81 + 16);
            const float rstd = 1.0f / sqrtf((lg[16 * 81 + lane] + lg[(16 * 81 + 16) + 16 * 81 + lane]) * (1.0f / DM) + EPS);
            float best = -3.0e38f; int gsel = 0; float glv[8];
#pragma unroll
            for (int j = 0; j < 8; ++j) { glv[j] = (lr[j] + lr2[j]) * rstd + F.rgb[j]; if (glv[j] > best) { best = glv[j]; gsel = j; } }
            float sum = 0.f;
#pragma unroll
            for (int j = 0; j < 8; ++j) sum += expf(glv[j] - best);
            const float gp = 1.0f / sum;
            float b1 = -3.0e38f, b2 = -3.0e38f; int i1 = 0, i2 = 0;
#pragma unroll
            for (int j = 0; j < 8; ++j) { const float v = (lr[8 + gsel * 8 + j] + lr2[8 + gsel * 8 + j]) * rstd + F.reb[gsel * 8 + j];
                if (v > b1) { b2 = b1; i2 = i1; b1 = v; i1 = j; } else if (v > b2) { b2 = v; i2 = j; } }
            const float e2 = expf(b2 - b1); const float w1 = gp / (1.0f + e2), w2 = gp * e2 / (1.0f + e2);
            F.RSTD2[token] = rstd;
            const int ex1 = gsel * 8 + i1, ex2 = gsel * 8 + i2;
            const unsigned p1 = atomicAdd(F.ctl + CW_CNT + 64 * ex1, 1u); F.LIST[ex1 * LISTCAP + p1] = token * 2; F.AW[token * 2] = w1; F.APOS[token * 2] = (ex1 << 16) | (int)p1;
            const unsigned p2 = atomicAdd(F.ctl + CW_CNT + 64 * ex2, 1u); F.LIST[ex2 * LISTCAP + p2] = token * 2 + 1; F.AW[token * 2 + 1] = w2; F.APOS[token * 2 + 1] = (ex2 << 16) | (int)p2;
        }
        __syncthreads();
    }
}

__device__ __forceinline__ void phase_final(Frame& F) {
    const int gw = F.vcu * 8 + F.wave, NGW = F.G * 8;
    const LAS int* tstart = (const LAS int*)(F.lds + TAB_OFF) + 64;
    u32x2 xa[16], pa[16], qa[16], xb[16], pb[16], qb[16]; float w0a, w1a, w0b, w1b;
#define FIN_LOAD(m, X, P, Q, W0, W1) do { const int ap0_ = F.APOS[2 * (m)], ap1_ = F.APOS[2 * (m) + 1]; W0 = F.AW[2 * (m)]; W1 = F.AW[2 * (m) + 1]; \
        const int row0_ = tstart[ap0_ >> 16] * 256 + (ap0_ & 0xffff), row1_ = tstart[ap1_ >> 16] * 256 + (ap1_ & 0xffff); \
        const u32x2* xr_ = (const u32x2*)(F.X1 + (size_t)(m) * DM) + F.lane; const u32x2* y0_ = (const u32x2*)(F.YT + (size_t)row0_ * DM) + F.lane; const u32x2* y1_ = (const u32x2*)(F.YT + (size_t)row1_ * DM) + F.lane; \
        _Pragma("unroll") for (int j = 0; j < 16; ++j) { X[j] = __builtin_nontemporal_load(xr_ + 64 * j); P[j] = __builtin_nontemporal_load(y0_ + 64 * j); Q[j] = __builtin_nontemporal_load(y1_ + 64 * j); } } while (0)
    int m = gw;
    if (m < NTOK) FIN_LOAD(m, xa, pa, qa, w0a, w1a);
    for (; m < NTOK; m += NGW) {
        const bool has = (m + NGW) < NTOK;
        if (has) FIN_LOAD(m + NGW, xb, pb, qb, w0b, w1b);
        f32x4* orow = (f32x4*)(F.out + (size_t)m * DM) + F.lane; const f32x4* gr = (const f32x4*)F.gf + F.lane;
        f32x4 v[16]; float ss = 0.f;
#pragma unroll
        for (int j = 0; j < 16; ++j) { const f32x4 a = (f32x4){bf_lo(xa[j].x), bf_hi(xa[j].x), bf_lo(xa[j].y), bf_hi(xa[j].y)};
            v[j].x = a.x + w0a * bf_lo(pa[j].x) + w1a * bf_lo(qa[j].x); v[j].y = a.y + w0a * bf_hi(pa[j].x) + w1a * bf_hi(qa[j].x); v[j].z = a.z + w0a * bf_lo(pa[j].y) + w1a * bf_lo(qa[j].y); v[j].w = a.w + w0a * bf_hi(pa[j].y) + w1a * bf_hi(qa[j].y);
            ss += (v[j].x * v[j].x + v[j].y * v[j].y) + (v[j].z * v[j].z + v[j].w * v[j].w); }
        ss = wave_sum(ss);
        const float rstd = 1.0f / sqrtf(ss * (1.0f / DM) + EPS);
#pragma unroll
        for (int j = 0; j < 16; ++j) __builtin_nontemporal_store(v[j] * rstd * gr[64 * j], orow + 64 * j);
        if (has) { w0a = w0b; w1a = w1b;
#pragma unroll
            for (int j = 0; j < 16; ++j) { xa[j] = xb[j]; pa[j] = pb[j]; qa[j] = qb[j]; } }
    }
#undef FIN_LOAD
}

__device__ __forceinline__ int moe_tables(Frame& F) {
    LAS int* cnts = (LAS int*)(F.lds + TAB_OFF); LAS int* tstart = cnts + 64; LAS int* tl = cnts + 144;
    __syncthreads();
    if (F.tid < 64) {
        const int e = F.tid, cnt = (int)F.ctl[CW_CNT + 64 * e]; cnts[e] = cnt;
        const int nt = (cnt + 255) >> 8, nsmall = (nt > 0 && cnt - 256 * (nt - 1) <= 128) ? 1 : 0, nbig = nt - nsmall;
        int pt = nt, pb = nbig, ps = nsmall;
#pragma unroll
        for (int o = 1; o < 64; o <<= 1) { const int a = __shfl_up(pt, o), b = __shfl_up(pb, o), c = __shfl_up(ps, o); if (e >= o) { pt += a; pb += b; ps += c; } }
        const int Tb = __shfl(pb, 63), T = __shfl(pt, 63);
        tstart[e] = pt - nt; if (e == 63) { tstart[64] = T; cnts[130] = Tb; }
        for (int t = 0; t < nbig; ++t) tl[pb - nbig + t] = (e << 8) | t;
        if (nsmall) tl[Tb + ps - 1] = (e << 8) | (nt - 1);
    }
    __syncthreads();
    return tstart[64];
}
__device__ __forceinline__ const float* in_ptr(LAS unsigned char* lds, int k) {
    const unsigned long long v = ((const LAS unsigned long long*)(lds + PTAB_OFF))[k];
    const unsigned lo = __builtin_amdgcn_readfirstlane((unsigned)v), hi = __builtin_amdgcn_readfirstlane((unsigned)(v >> 32));
    return (const float*)(const GAS float*)(((unsigned long long)hi << 32) | lo);
}
constexpr int N_PHASES = 10;
struct Args { const float* in[19]; float* out; unsigned char* ws; int ph_lo, ph_hi, li, pad; };
__global__ void __launch_bounds__(512, 2) fwd_kernel(Args args) {
    extern __shared__ __attribute__((aligned(16))) unsigned char lds_raw[];
    Frame F;
    F.lds = (LAS unsigned char*)lds_raw;
    volatile LAS unsigned* MISC = (volatile LAS unsigned*)(F.lds + MISC_OFF);
    F.tid = threadIdx.x; F.lane = F.tid & 63; F.wave = __builtin_amdgcn_readfirstlane(F.tid >> 6);
    F.G = gridDim.x; { const int bx = blockIdx.x; F.vcu = (F.G % 8 == 0) ? (bx % 8) * (F.G / 8) + bx / 8 : bx; }
    unsigned char* ws = args.ws;
    F.ctl = (unsigned*)(ws + WS_CTL);
    F.out = args.out;
    for (int u = F.tid; u < 128; u += 512) ((LAS unsigned*)(F.lds + MISC_OFF))[u] = 0u;
    __syncthreads();
    if (F.tid == 0) { LAS unsigned long long* pt = (LAS unsigned long long*)(F.lds + PTAB_OFF);
#pragma unroll
        for (int k = 0; k < 19; ++k) pt[k] = (unsigned long long)args.in[k]; }
    __syncthreads();
#define INP(k) in_ptr(F.lds, (k))
#define WSP(T, off) ((T*)(ws + (off)))
    XcdBarrier bar; bar.bar = F.ctl + CW_BAR; bar.x = 0; bar.st = nullptr;
    if (MK_N_LAUNCHES == 1) bar = xcd_barrier_post(F.ctl + CW_BAR, MISC + 8);
    const int lo = args.ph_lo, hi = args.ph_hi;
#ifndef PHASE_MASK
#define PHASE_MASK 0x3ff
#endif
#define IN(k) ((((PHASE_MASK) >> (k)) & 1) && lo <= (k) && (k) < hi)
#define RELANE() do { int l_ = (int)__builtin_amdgcn_mbcnt_hi(~0u, __builtin_amdgcn_mbcnt_lo(~0u, 0u)); asm volatile("" : "+v"(l_)); F.lane = l_; F.tid = F.wave * 64 + F.lane; } while (0)
#define SEAM(k) do { if (IN(k) && IN((k) + 1)) xcd_barrier(bar, F.wave == 0 && __builtin_amdgcn_mbcnt_hi(~0u, __builtin_amdgcn_mbcnt_lo(~0u, 0u)) == 0u); } while (0)
#ifndef REPS_MASK
#define REPS_MASK 0
#endif
#define NREP(k) ((((REPS_MASK) >> (k)) & 1) ? 2 : 1)

    if (IN(0)) { RELANE(); F.g2 = INP(10); F.x = INP(0); F.g1 = INP(1); F.w_in = INP(2); F.w_out = INP(9); F.rgw = INP(11); F.rew = INP(13); F.wg = INP(15); F.wu = INP(16); F.wd = INP(17);
        F.ACT = WSP(bf16_t, WS_ACT); F.GATES = WSP(float, WS_GATES); F.WIN_T = WSP(bf16_t, WS_WIN); F.WOUT_T = WSP(bf16_t, WS_WOUT); F.WGU_T = WSP(bf16_t, WS_WGU); F.WD_T = WSP(bf16_t, WS_WD); F.WRT = WSP(bf16_t, WS_WRT);
        for (int rep = 0; rep < NREP(0); ++rep) { phase0(F); RELANE(); phase0b(F); __syncthreads(); } } SEAM(0);
    if (IN(1)) { RELANE();
        { const int gsb = (F.G >= NCONV + 16 && F.G > 2 * NCONV) ? NCONV : 0;
          if ((int)blockIdx.x >= gsb && (int)blockIdx.x < gsb + 16) { F.igb = INP(6); F.fgb = INP(7); F.GATES = WSP(float, WS_GATES); F.GS = WSP(float, WS_GS); for (int bh = (int)blockIdx.x - gsb; bh < 16; bh += F.G) phase_gates(F, bh); RELANE(); } }
        if ((int)blockIdx.x < NCONV && F.G > 2 * NCONV) {
            F.g2 = INP(10); F.wg = INP(15); F.wu = INP(16); F.wd = INP(17); F.WGU_T = WSP(bf16_t, WS_WGU); F.WD_T = WSP(bf16_t, WS_WD); F.w_in = INP(2); F.w_out = INP(9); F.WIN_T = WSP(bf16_t, WS_WIN); F.WOUT_T = WSP(bf16_t, WS_WOUT);
            phase_convert(F, ITEMS_DENSE, NITEMS, (int)blockIdx.x * 8 + F.wave, -(NCONV * 8)); __syncthreads();
        } else if (F.G <= 2 * NCONV) {
            F.g2 = INP(10); F.wg = INP(15); F.wu = INP(16); F.wd = INP(17); F.WGU_T = WSP(bf16_t, WS_WGU); F.WD_T = WSP(bf16_t, WS_WD); F.w_in = INP(2); F.w_out = INP(9); F.WIN_T = WSP(bf16_t, WS_WIN); F.WOUT_T = WSP(bf16_t, WS_WOUT);
            phase_convert(F, ITEMS_DENSE, NITEMS, F.vcu * 8 + F.wave, F.G * 8); __syncthreads(); }
        { pg8::DynSched<4096> S; S.init(NTOK, NPROJ, WSP(bf16_t, WS_ACT), WSP(bf16_t, WS_WIN), F.ctl + CW_Q1, (volatile LAS int*)(F.lds + TAB_OFF), (int)xb_xcc_id()); S.t0 = (F.tid == 0); S.prime();
          pg8::EpiProj E{WSP(bf16_t, WS_PROJ), WSP(bf16_t, WS_QH), WSP(bf16_t, WS_KH), WSP(bf16_t, WS_VH), WSP(float, WS_VSSP)};
          pg8::gemm_phase<pg8::EpiProj, pg8::DynSched<4096>, 4096>(F.lds, S, E, F.wave, F.lane); }
        } SEAM(1);
    if (IN(2)) { RELANE(); F.gvn = INP(3); F.gsw = INP(4); F.gsb = INP(5); F.igb = INP(6); F.fgb = INP(7);
        F.PROJ = WSP(bf16_t, WS_PROJ); F.ACT = WSP(bf16_t, WS_ACT); F.GATES = WSP(float, WS_GATES); F.HB = WSP(float, WS_HB); F.QH = WSP(bf16_t, WS_QH); F.KH = WSP(bf16_t, WS_KH); F.VH = WSP(bf16_t, WS_VH); F.VSSP = WSP(float, WS_VSSP); F.GS = WSP(float, WS_GS);
#ifndef P2_SEL
#define P2_SEL 3
#endif
        F.PM = WSP(bf16_t, WS_PM); F.KP = WSP(bf16_t, WS_KP); phase_mlstm_pre(F);
        if (MK_N_LAUNCHES == 1) xcd_barrier(bar, F.wave == 0 && __builtin_amdgcn_mbcnt_hi(~0u, __builtin_amdgcn_mbcnt_lo(~0u, 0u)) == 0u);
        RELANE();
        for (int rep = 0; rep < NREP(9); ++rep) phase_mlstm(F); RELANE(); for (int rep = 0; rep < NREP(10); ++rep) phase_gmlp(F); } SEAM(2);
    if (IN(3)) { RELANE(); F.ogn = INP(8); F.PROJ = WSP(bf16_t, WS_PROJ); F.ACT = WSP(bf16_t, WS_ACT); F.HB = WSP(float, WS_HB); for (int rep = 0; rep < NREP(3); ++rep) phase_mlnorm(F); } SEAM(3);
    if (IN(4)) { RELANE(); pg8::DenseSched<4096> S; S.init(NTOK, DM, F.G, (int)blockIdx.x, WSP(bf16_t, WS_ACT), WSP(bf16_t, WS_WOUT)); pg8::EpiRes E{INP(0), WSP(bf16_t, WS_X1)};
        pg8::gemm_phase<pg8::EpiRes, pg8::DenseSched<4096>, 4096>(F.lds, S, E, F.wave, F.lane);
        if (NREP(4) == 2) { __syncthreads(); pg8::gemm_phase<pg8::EpiRes, pg8::DenseSched<4096>, 4096>(F.lds, S, E, F.wave, F.lane); } } SEAM(4);
    if (IN(5)) { RELANE(); F.g2 = INP(10); F.rgb = INP(12); F.reb = INP(14); F.ACT = WSP(bf16_t, WS_ACT); F.WRT = WSP(bf16_t, WS_WRT); F.RSTD2 = WSP(float, WS_RSTD2); F.AW = WSP(float, WS_AW); F.LIST = WSP(int, WS_LIST); F.APOS = WSP(int, WS_APOS); F.X1 = WSP(bf16_t, WS_X1);
        phase_router(F); } SEAM(5);
#define MOE_SCHED_INIT(S) do { S.cnts = (const LAS int*)(F.lds + TAB_OFF); S.tstart = S.cnts + 64; S.tl = S.cnts + 144; S.G = F.G; S.c = F.vcu; S.list = WSP(int, WS_LIST); S.ctr = nullptr; S.slot = nullptr; S.t0 = false; } while (0)
#define MOE_GU(S) do { S.A = (const char*)WSP(bf16_t, WS_X1); S.Bt = (const char*)WSP(bf16_t, WS_WGU); S.bexp = (size_t)1024 * DM * 2; } while (0)
#define MOE_DN(S) do { S.A = (const char*)WSP(bf16_t, WS_HM); S.Bt = (const char*)WSP(bf16_t, WS_WD); S.bexp = (size_t)DM * DEXP * 2; } while (0)
    if (IN(6)) { RELANE(); const int T = moe_tables(F); const int U6 = (T * 4 < ((2 * F.G) & ~3)) ? T * 4 : ((2 * F.G) & ~3);
        pg8::MoeSched<4096, 2, true> S; MOE_SCHED_INIT(S); MOE_GU(S); S.u_lo = 0; S.u_hi = U6;
        pg8::EpiGU E{WSP(bf16_t, WS_HM), WSP(int, WS_LIST), WSP(float, WS_RSTD2)};
        pg8::gemm_phase<pg8::EpiGU, pg8::MoeSched<4096, 2, true>, 4096, true>(F.lds, S, E, F.wave, F.lane); } SEAM(6);
    if (IN(7)) { RELANE(); const int T = ((const LAS int*)(F.lds + TAB_OFF))[128];     const int U6 = (T * 4 < ((2 * F.G) & ~3)) ? T * 4 : ((2 * F.G) & ~3); const int T6 = U6 >> 2;
        { pg8::MoeSched<4096, 2, true, true> S; MOE_SCHED_INIT(S); MOE_GU(S); S.u_lo = U6; S.u_hi = T * 4; S.ctr = F.ctl + CW_QA; S.slot = (volatile LAS int*)(F.lds + TAB_OFF + 1408); S.t0 = (F.tid == 0); S.prime();
          pg8::EpiGU E{WSP(bf16_t, WS_HM), WSP(int, WS_LIST), WSP(float, WS_RSTD2)};
          pg8::gemm_phase<pg8::EpiGU, pg8::MoeSched<4096, 2, true, true>, 4096, true>(F.lds, S, E, F.wave, F.lane); }
        __syncthreads(); RELANE();
        { pg8::MoeSched<512, 4, false, true> S; MOE_SCHED_INIT(S); MOE_DN(S); S.u_lo = 0; S.u_hi = T6 * 16; S.ctr = F.ctl + CW_QB; S.slot = (volatile LAS int*)(F.lds + TAB_OFF + 1440); S.t0 = (F.tid == 0); S.prime();
          pg8::EpiDown E{WSP(bf16_t, WS_YT)};
          pg8::gemm_phase<pg8::EpiDown, pg8::MoeSched<512, 4, false, true>, 512, true>(F.lds, S, E, F.wave, F.lane); } } SEAM(7);
    if (IN(8)) { RELANE(); const int T = ((const LAS int*)(F.lds + TAB_OFF))[128]; const int U6 = (T * 4 < ((2 * F.G) & ~3)) ? T * 4 : ((2 * F.G) & ~3); const int T6 = U6 >> 2;
        pg8::MoeSched<512, 4, false> S; MOE_SCHED_INIT(S); MOE_DN(S); S.u_lo = T6 * 16; S.u_hi = T * 16;
        pg8::EpiDown E{WSP(bf16_t, WS_YT)};
        pg8::gemm_phase<pg8::EpiDown, pg8::MoeSched<512, 4, false>, 512, true>(F.lds, S, E, F.wave, F.lane); } SEAM(8);
    if (IN(9)) { RELANE(); F.gf = INP(18); F.YT = WSP(bf16_t, WS_YT); F.AW = WSP(float, WS_AW); F.APOS = WSP(int, WS_APOS); F.X1 = WSP(bf16_t, WS_X1);
        phase_final(F); }
#undef IN
#undef SEAM
}

extern "C" void kernel_launch(void* const* d_in, const int* in_sizes, int n_in, void* d_out, int out_size, void* d_ws, size_t ws_size, hipStream_t stream) {
    static int grid = 0;
    if (grid == 0) {
        if (n_in != 19 || out_size != NTOK * DM || ws_size < WS_END) { fprintf(stderr, "kernel_launch: unexpected shapes (n_in %d, out %d, ws %zu)\n", n_in, out_size, ws_size); grid = -1; return; }
        int dev = 0, cus = 0, per_cu = 0;
        if (hipGetDevice(&dev) != hipSuccess || hipDeviceGetAttribute(&cus, hipDeviceAttributeMultiprocessorCount, dev) != hipSuccess) { grid = -1; return; }
        if (hipFuncSetAttribute((const void*)fwd_kernel, hipFuncAttributeMaxDynamicSharedMemorySize, LDS_BYTES) != hipSuccess) { fprintf(stderr, "kernel_launch: hipFuncSetAttribute failed\n"); grid = -1; return; }
        if (hipOccupancyMaxActiveBlocksPerMultiprocessor(&per_cu, (const void*)fwd_kernel, 512, LDS_BYTES) != hipSuccess || per_cu < 1) fprintf(stderr, "kernel_launch: occupancy query reports %d\n", per_cu);
        (void)hipGetLastError();
        grid = cus;
    }
    if (grid < 0) return;
    if (hipMemsetAsync((char*)d_ws + WS_CTL, 0, CTL_ZERO_BYTES, stream) != hipSuccess) return;
    Args a{};
    for (int i = 0; i < 19; ++i) a.in[i] = (const float*)d_in[i];
    a.out = (float*)d_out; a.ws = (unsigned char*)d_ws; a.pad = 0;
    if (MK_N_LAUNCHES == 1) { a.ph_lo = 0; a.ph_hi = N_PHASES; a.li = 0; hipLaunchKernelGGL(fwd_kernel, dim3(grid), dim3(512), LDS_BYTES, stream, a); }
    else for (int li = 0; li < N_PHASES; ++li) { a.ph_lo = li; a.ph_hi = li + 1; a.li = li; hipLaunchKernelGGL(fwd_kernel, dim3(grid), dim3(512), LDS_BYTES, stream, a); }
}
```
